# Optimizing an MI355X kernel written in HIP

```python
import math
import jax, jax.numpy as jnp
from jax import lax
import numpy as np

D_MODEL = 2048
BATCH = 4
SEQ = 4096
DEPTH = 1

GRID_W = 64
CTX_LEN = 256

D_SSD = D_MODEL
SSD_HEAD_DIM = 64
SSD_HEADS = D_SSD // SSD_HEAD_DIM
SSD_GROUPS = 8
SSD_REP = SSD_HEADS // SSD_GROUPS
SSD_STATE = 128
SSD_CONV = 3
SSD_CHUNK = 128

D_POOL = D_MODEL
POOL_WINDOWS = (2, 4, 8, 16)
POOL_GROUPS = len(POOL_WINDOWS)
POOL_GW = D_POOL // POOL_GROUPS

D_FF = 5632
FFN_CONV = 3

EPS = 1e-6

COL_DT = 2 * SSD_HEADS
COL_BC = SSD_GROUPS * SSD_STATE
N_XBC = D_SSD + 2 * COL_BC
N_STATE_COLS = COL_DT + D_SSD + COL_BC
IN_SIZES = (COL_DT, N_XBC, D_SSD, D_POOL, D_MODEL, D_MODEL)
IN_COLS = sum(IN_SIZES)

kernel_name = "hybrid_ssd_pool_convglu_prefix_block"


def rms_norm(x, w):
    x32 = x.astype(jnp.float32)
    y = x32 * lax.rsqrt(jnp.mean(x32 * x32, axis=-1, keepdims=True) + EPS)
    return (y * w.astype(jnp.float32)).astype(x.dtype)


def modulate(x, w, shift, scale):
    return rms_norm(x, w) * (1 + scale) + shift


def dwconv_axis1(x, w, b):
    k = w.shape[0]
    n = x.shape[1]
    p = k // 2
    xp = jnp.pad(x, [(0, 0), (p, p)] + [(0, 0)] * (x.ndim - 2))
    out = xp[:, 0:n] * w[0] + b
    for j in range(1, k):
        out = out + xp[:, j:j + n] * w[j]
    return out


def centred_pool_residual(v, window):
    n = v.shape[-2]
    v32 = v.astype(jnp.float32)
    csum = jnp.cumsum(v32, axis=-2)
    prefix = jnp.pad(csum, [(0, 0)] * (v.ndim - 2) + [(1, 0), (0, 0)])
    t = jnp.arange(n)
    start = jnp.clip(t - window // 2, 0, n)
    end = jnp.clip(t + window - window // 2, 0, n)
    total = jnp.take(prefix, end, axis=-2) - jnp.take(prefix, start, axis=-2)
    count = (end - start).astype(jnp.float32)[:, None]
    return (total / count - v32).astype(v.dtype)


def pool_mixer(v, pool_w, pool_scale, grid):
    b, l, _ = v.shape
    if grid:
        v = v.reshape(b, l // GRID_W, GRID_W, D_POOL)
    groups = jnp.split(v, POOL_GROUPS, axis=-1)
    p = jnp.stack([centred_pool_residual(g, w) for g, w in zip(groups, POOL_WINDOWS)], axis=-2)
    p = jnp.einsum('...gi,gio->...go', p, pool_w).reshape(b, l, D_POOL)
    return p * pool_scale


def _ssd_chunks(xs, dt, A, B):
    b, l = xs.shape[:2]
    nc = l // SSD_CHUNK
    xd = (xs.astype(jnp.float32) * dt[..., None]).reshape(b, nc, SSD_CHUNK, SSD_GROUPS, SSD_REP, SSD_HEAD_DIM)
    a_cs = jnp.cumsum((dt * A).reshape(b, nc, SSD_CHUNK, SSD_GROUPS, SSD_REP), axis=2)
    bc = B.astype(jnp.float32).reshape(b, nc, SSD_CHUNK, SSD_GROUPS, SSD_STATE)
    return xd, a_cs, bc


def _ssd_carry(xd, a_cs, bc, h0):
    decay_to_end = jnp.exp(a_cs[:, :, -1:] - a_cs)
    states = jnp.einsum('bcsgn,bcsgr,bcsgrp->bcgrpn', bc, decay_to_end, xd)
    chunk_decay = jnp.exp(a_cs[:, :, -1])

    def step(h, inp):
        s, d = inp
        return h * d[..., None, None] + s, h

    h_final, h_in = lax.scan(step, h0, (jnp.moveaxis(states, 1, 0), jnp.moveaxis(chunk_decay, 1, 0)))
    return jnp.moveaxis(h_in, 0, 1), h_final


def ssd_scan(xs, dt, A, B, C, d_skip, h0):
    xd, a_cs, bc = _ssd_chunks(xs, dt, A, B)
    h_in, h_final = _ssd_carry(xd, a_cs, bc, h0)
    b, nc = xd.shape[:2]
    cc = C.astype(jnp.float32).reshape(b, nc, SSD_CHUNK, SSD_GROUPS, SSD_STATE)
    seg = a_cs[:, :, :, None] - a_cs[:, :, None]
    order = jnp.tril(jnp.ones((SSD_CHUNK, SSD_CHUNK), dtype=bool))[:, :, None, None]
    decay = jnp.exp(jnp.where(order, seg, -jnp.inf))
    cb = jnp.einsum('bclgn,bcsgn->bclsg', cc, bc)
    y_diag = jnp.einsum('bclsg,bclsgr,bcsgrp->bclgrp', cb, decay, xd)
    y_off = jnp.einsum('bclgn,bcgrpn,bclgr->bclgrp', cc, h_in, jnp.exp(a_cs))
    y = (y_diag + y_off).reshape(xs.shape) + d_skip[..., None] * xs.astype(jnp.float32)
    return y, h_final


def _flip(t):
    return jnp.flip(t, axis=1)


def _ssd_prepare(dt_raw, xbc, conv_w, conv_b, dt_bias, a_log):
    b, l, _ = xbc.shape
    xbc = jax.nn.silu(dwconv_axis1(xbc, conv_w, conv_b))
    xs = xbc[..., :D_SSD].reshape(b, l, SSD_GROUPS, SSD_REP, SSD_HEAD_DIM)
    B = xbc[..., D_SSD:D_SSD + COL_BC].reshape(b, l, SSD_GROUPS, SSD_STATE)
    rest = xbc[..., D_SSD + COL_BC:]
    dt = jax.nn.softplus(dt_raw.astype(jnp.float32).reshape(b, l, 2, SSD_GROUPS, SSD_REP)
                         + dt_bias.astype(jnp.float32).reshape(2, SSD_GROUPS, SSD_REP))
    A = -jnp.exp(a_log.astype(jnp.float32)).reshape(2, SSD_GROUPS, SSD_REP)
    return xs, B, rest, dt, A


def _zero_state(b):
    return jnp.zeros((b, SSD_GROUPS, SSD_REP, SSD_HEAD_DIM, SSD_STATE), jnp.float32)


def context_ssd_states(h, lp):
    b = h.shape[0]
    proj = h @ lp['w_in'][:, :N_STATE_COLS]
    xs, B, _, dt, A = _ssd_prepare(proj[..., :COL_DT], proj[..., COL_DT:],
                                   lp['ssd_conv_w'][:, :D_SSD + COL_BC], lp['ssd_conv_b'][:D_SSD + COL_BC],
                                   lp['dt_bias'], lp['a_log'])
    xd, a_cs, bc = _ssd_chunks(xs, dt[:, :, 0], A[0], B)
    h_f = _ssd_carry(xd, a_cs, bc, _zero_state(b))[1]
    xd, a_cs, bc = _ssd_chunks(_flip(xs), _flip(dt[:, :, 1]), A[1], _flip(B))
    h_b = _ssd_carry(xd, a_cs, bc, _zero_state(b))[1]
    return h_f, h_b


def token_mixer(h, lp, h0_f, h0_b, grid):
    b, l, _ = h.shape
    proj = h @ lp['w_in']
    idx = np.cumsum(IN_SIZES)[:-1].tolist()
    dt_raw, xbc, z, v, g_ssd, g_pool = jnp.split(proj, idx, axis=-1)

    xs, B, c_flat, dt, A = _ssd_prepare(dt_raw, xbc, lp['ssd_conv_w'], lp['ssd_conv_b'], lp['dt_bias'], lp['a_log'])
    C = c_flat.reshape(b, l, SSD_GROUPS, SSD_STATE)
    d_skip = lp['d_skip'].astype(jnp.float32).reshape(2, SSD_GROUPS, SSD_REP)
    y_f, h_f = ssd_scan(xs, dt[:, :, 0], A[0], B, C, d_skip[0], h0_f)
    y_b, h_b = ssd_scan(_flip(xs), _flip(dt[:, :, 1]), A[1], _flip(B), _flip(C), d_skip[1], h0_b)
    y = (y_f + _flip(y_b)).reshape(b, l, D_SSD)
    gated = (y * jax.nn.silu(z.astype(jnp.float32))).reshape(b, l, SSD_GROUPS, D_SSD // SSD_GROUPS)
    y_ssd = rms_norm(gated, lp['ssd_norm_w'].reshape(SSD_GROUPS, -1)).reshape(b, l, D_SSD).astype(h.dtype)

    y_pool = pool_mixer(v, lp['pool_w'], lp['pool_scale'], grid)

    merged = (jax.nn.sigmoid(g_ssd) * (y_ssd @ lp['w_ssd_out'])
              + jax.nn.sigmoid(g_pool) * (y_pool @ lp['w_pool_out']))
    return merged @ lp['w_o'], h_f, h_b


def conv_ffn(h, lp, grid):
    b, l, _ = h.shape
    a, g = jnp.split(h @ lp['w_up'], 2, axis=-1)
    if grid:
        g = g.reshape(b, l // GRID_W, GRID_W, D_FF)
    g = dwconv_axis1(g, lp['ffn_conv_w'], lp['ffn_conv_b']).reshape(b, l, D_FF)
    return (jax.nn.gelu(g, approximate=False) * a) @ lp['w_down']


def setup_inputs(seed: int = 0) -> dict:
    key = jax.random.key(seed)
    ks = jax.random.split(key, 28)
    f32 = jnp.float32

    def nrm(k, shape, scale):
        return jax.random.normal(k, shape, f32) * scale

    dt0 = jnp.exp(jax.random.uniform(ks[10], (DEPTH, 2, SSD_HEADS), f32,
                                     minval=math.log(1e-3), maxval=math.log(1e-1)))
    return {
        "x": nrm(ks[0], (BATCH, SEQ, D_MODEL), 1.0),
        "c": nrm(ks[1], (BATCH, D_MODEL), 1.0),
        "ctx": nrm(ks[2], (BATCH, CTX_LEN, D_MODEL), 1.0),
        "c_ctx": nrm(ks[3], (D_MODEL,), 1.0),
        "w_ada": nrm(ks[4], (DEPTH, D_MODEL, 6 * D_MODEL), 0.5 * D_MODEL ** -0.5),
        "b_ada": nrm(ks[5], (DEPTH, 6 * D_MODEL), 0.01),
        "norm1_w": 1.0 + nrm(ks[6], (DEPTH, D_MODEL), 0.02),
        "w_in": nrm(ks[7], (DEPTH, D_MODEL, IN_COLS), D_MODEL ** -0.5),
        "ssd_conv_w": nrm(ks[8], (DEPTH, SSD_CONV, N_XBC), SSD_CONV ** -0.5),
        "ssd_conv_b": nrm(ks[9], (DEPTH, N_XBC), 0.01),
        "dt_bias": dt0 + jnp.log(-jnp.expm1(-dt0)),
        "a_log": jnp.log(jax.random.uniform(ks[11], (DEPTH, 2, SSD_HEADS), f32, minval=1.0, maxval=16.0)),
        "d_skip": 1.0 + nrm(ks[12], (DEPTH, 2, SSD_HEADS), 0.1),
        "ssd_norm_w": 1.0 + nrm(ks[13], (DEPTH, D_SSD), 0.02),
        "w_ssd_out": nrm(ks[14], (DEPTH, D_SSD, D_MODEL), D_SSD ** -0.5),
        "pool_w": nrm(ks[15], (DEPTH, POOL_GROUPS, POOL_GW, POOL_GW), POOL_GW ** -0.5),
        "pool_scale": 1.0 + nrm(ks[16], (DEPTH, D_POOL), 0.02),
        "w_pool_out": nrm(ks[17], (DEPTH, D_POOL, D_MODEL), D_POOL ** -0.5),
        "w_o": nrm(ks[18], (DEPTH, D_MODEL, D_MODEL), D_MODEL ** -0.5),
        "norm2_w": 1.0 + nrm(ks[19], (DEPTH, D_MODEL), 0.02),
        "w_up": nrm(ks[20], (DEPTH, D_MODEL, 2 * D_FF), D_MODEL ** -0.5),
        "ffn_conv_w": nrm(ks[21], (DEPTH, FFN_CONV, D_FF), FFN_CONV ** -0.5),
        "ffn_conv_b": nrm(ks[22], (DEPTH, D_FF), 0.01),
        "w_down": nrm(ks[23], (DEPTH, D_FF, D_MODEL), D_FF ** -0.5),
        "final_norm_w": 1.0 + nrm(ks[24], (D_MODEL,), 0.02),
    }


def reference(x, c, ctx, c_ctx, w_ada, b_ada, norm1_w, w_in, ssd_conv_w, ssd_conv_b, dt_bias, a_log,
              d_skip, ssd_norm_w, w_ssd_out, pool_w, pool_scale, w_pool_out, w_o, norm2_w, w_up,
              ffn_conv_w, ffn_conv_b, w_down, final_norm_w):
    x_lat = x
    x_ctx = ctx
    for i in range(DEPTH):
        lp = {
            'w_in': w_in[i], 'ssd_conv_w': ssd_conv_w[i], 'ssd_conv_b': ssd_conv_b[i],
            'dt_bias': dt_bias[i], 'a_log': a_log[i], 'd_skip': d_skip[i], 'ssd_norm_w': ssd_norm_w[i],
            'w_ssd_out': w_ssd_out[i], 'pool_w': pool_w[i], 'pool_scale': pool_scale[i],
            'w_pool_out': w_pool_out[i], 'w_o': w_o[i], 'w_up': w_up[i], 'ffn_conv_w': ffn_conv_w[i],
            'ffn_conv_b': ffn_conv_b[i], 'w_down': w_down[i],
        }
        mod_lat = (jax.nn.silu(c) @ w_ada[i] + b_ada[i])[:, None, :]
        mod_ctx = (jax.nn.silu(c_ctx) @ w_ada[i] + b_ada[i])[None, None, :]
        sh1, sc1, g1, sh2, sc2, g2 = jnp.split(mod_lat, 6, axis=-1)
        csh1, csc1, cg1, csh2, csc2, cg2 = jnp.split(mod_ctx, 6, axis=-1)

        h_ctx = modulate(x_ctx, norm1_w[i], csh1, csc1)
        if i == DEPTH - 1:
            h0_f, h0_b = context_ssd_states(h_ctx, lp)
        else:
            zero = _zero_state(x_ctx.shape[0])
            out_ctx, h0_f, h0_b = token_mixer(h_ctx, lp, zero, zero, grid=False)
            x_ctx = x_ctx + cg1 * out_ctx
            x_ctx = x_ctx + cg2 * conv_ffn(modulate(x_ctx, norm2_w[i], csh2, csc2), lp, grid=False)

        h_lat = modulate(x_lat, norm1_w[i], sh1, sc1)
        out_lat, _, _ = token_mixer(h_lat, lp, h0_f, h0_b, grid=True)
        x_lat = x_lat + g1 * out_lat
        x_lat = x_lat + g2 * conv_ffn(modulate(x_lat, norm2_w[i], sh2, sc2), lp, grid=True)
    return rms_norm(x_lat, final_norm_w)
```

```cpp
#include <hip/hip_runtime.h>
#include <hip/hip_cooperative_groups.h>
#include <cstdio>
#include <cstdint>
namespace cg = cooperative_groups;

#ifndef MK_MULTI
#define MK_MULTI 0
#endif

namespace pg8 {
#define PG8_LAS __attribute__((address_space(3)))
typedef unsigned short bf16_t;
typedef short bf16x8 __attribute__((ext_vector_type(8)));
typedef float f32x4 __attribute__((ext_vector_type(4)));
typedef unsigned u32x4 __attribute__((ext_vector_type(4)));
constexpr int BM = 256, BK = 64, HALF = 128, HTB = HALF * BK * 2, STAGE_BYTES = 8 * HTB, NXCD = 8, WGM = 2;

__host__ __device__ __forceinline__ int lds_byte(int r, int c) { const int st = (r >> 4) * 2 + (c >> 5), rr = r & 15, cc = c & 31, ob = rr * 64 + cc * 2; return st * 1024 + (ob ^ (((ob >> 9) & 1) << 5)); }
__host__ __device__ __forceinline__ void stage_rc(int b, int& R, int& C) { const int st = b / 1024, sb = b % 1024, swz = sb ^ (((sb >> 9) & 1) << 5); R = (st >> 1) * 16 + swz / 64; C = (st & 1) * 32 + (swz % 64) / 2; }
__host__ __device__ __forceinline__ int perm32(int rho) { const int n = rho >> 4, i = rho & 15; return 8 * (i >> 2) + 4 * n + (i & 3); }

struct Unit { int pm, pn, half; };
struct Gemm { const bf16_t* A; const bf16_t* Bt; int lda, ldb, K, agrp; const bf16_t* A2; const bf16_t* Bt2; };

struct Order {
    int nM, nN, nwg, G, c, xM0, xnM, xn, xlast, dual;
    __device__ void init(int nM_, int nN_, int G_, int c_) { nM = nM_; nN = nN_; nwg = nM * nN; G = G_; c = c_; xM0 = 0; xnM = 0; xn = 0; xlast = 0; dual = 0; }
    __device__ bool next(int i_, Unit& u) const {
        const int i = dual ? (i_ >> 1) : i_; u.half = dual ? (i_ & 1) : 0;
        const long L = (long)i * G + c;
        if (L >= nwg) { const int e = (int)(L - nwg); if (e >= xnM * xn) return false; const int j = e / xnM; u.pm = xM0 + e % xnM; u.pn = (j < xn - 1) ? j : xlast; return true; }
        int wgid = (int)L; { const int q = nwg / NXCD, r = nwg % NXCD, xcd = wgid % NXCD, off = wgid / NXCD; wgid = (xcd < r ? xcd * (q + 1) : r * (q + 1) + (xcd - r) * q) + off; }
        const int nig = WGM * nN, gid = wgid / nig, fm = gid * WGM, gsz = (nM - fm) < WGM ? (nM - fm) : WGM;
        u.pm = fm + ((wgid % nig) % gsz); u.pn = (wgid % nig) / gsz; return true;
    }
};

__device__ __forceinline__ unsigned cvt_pk_bf16(float lo, float hi) { unsigned r; asm volatile("v_cvt_pk_bf16_f32 %0, %1, %2" : "=v"(r) : "v"(lo), "v"(hi)); return r; }

template <class Epi, class Sched>
__device__ __forceinline__ void gemm_phase(PG8_LAS unsigned char* lds, const Gemm g, const Sched& S, const Epi& E) {
    const int tid = threadIdx.x, wid = __builtin_amdgcn_readfirstlane(tid >> 6), lane = tid & 63, wr = wid >> 2, wc = wid & 3, fr = lane & 15, fq = lane >> 4;
    const int K = g.K, nt = K / BK;
    unsigned voffA[2], voffB[2];
#pragma unroll
    for (int i = 0; i < 2; ++i) { int R, C; stage_rc(tid * 16 + i * 8192, R, C); const int Rb = (R & ~31) + perm32(R & 31);
        voffA[i] = (unsigned)(R * g.lda + C) * 2u; voffB[i] = (unsigned)(Rb * g.ldb + C) * 2u; }
    const size_t kstep = (size_t)(BK * 2);
    const size_t hstepA = (size_t)HALF * g.lda * 2, hstepB = (size_t)HALF * g.ldb * 2;
    const size_t tstepA = 2 * hstepA, tstepB = 2 * hstepB;
    const unsigned ldsw = (unsigned)wid * 1024u;
    const int aoff = lds_byte(wr * 64 + fr, fq * 8), boff = lds_byte(wc * 32 + fr, fq * 8);
#define PG8_SA(b, h) (((b) * 2 + (h)) * HTB)
#define PG8_SB(b, h) ((4 + (b) * 2 + (h)) * HTB)
#define PG8_STAGE(bufoff, gbase, voff) do { _Pragma("unroll") for (int _i = 0; _i < 2; ++_i) \
        __builtin_amdgcn_global_load_lds((const unsigned*)((const char*)(gbase) + (voff)[_i]), (PG8_LAS unsigned*)(lds + (bufoff) + ldsw + _i * 8192), 16, 0, 0); } while (0)
#define PG8_LDA(dst, b, h) do { _Pragma("unroll") for (int m = 0; m < 4; ++m) _Pragma("unroll") for (int k = 0; k < 2; ++k) dst[m][k] = *(const PG8_LAS bf16x8*)(lds + PG8_SA(b, h) + aoff + m * 2048 + k * 1024); } while (0)
#define PG8_LDB(dst, b, h) do { _Pragma("unroll") for (int n = 0; n < 2; ++n) _Pragma("unroll") for (int k = 0; k < 2; ++k) dst[n][k] = *(const PG8_LAS bf16x8*)(lds + PG8_SB(b, h) + boff + n * 2048 + k * 1024); } while (0)
#define PG8_MMA(ai, bj, At, Bt) do { __builtin_amdgcn_s_setprio(1); _Pragma("unroll") for (int m = 0; m < 4; ++m) _Pragma("unroll") for (int n = 0; n < 2; ++n) _Pragma("unroll") for (int k = 0; k < 2; ++k) \
        acc[ai][bj][m][n] = __builtin_amdgcn_mfma_f32_16x16x32_bf16(Bt[n][k], At[m][k], acc[ai][bj][m][n], 0, 0, 0); __builtin_amdgcn_s_setprio(0); } while (0)
#define PG8_WAIT_V(n) asm volatile("s_waitcnt vmcnt(" #n ")" ::: "memory")
#define PG8_WAIT_L(n) asm volatile("s_waitcnt lgkmcnt(" #n ")" ::: "memory")
#define PG8_BAR __builtin_amdgcn_s_barrier()
#define PG8_SCHED __builtin_amdgcn_sched_barrier(0)
#define PG8_ABASE(u) ((const char*)((u).half ? g.A2 : g.A) + (size_t)(u).pm * tstepA + (g.agrp ? (size_t)((u).pn / g.agrp) * (size_t)K * 2 : (size_t)0))
#define PG8_BBASE(u) ((const char*)((u).half ? g.Bt2 : g.Bt) + (size_t)(u).pn * tstepB)
    Unit cur, nxt; int ui = 0;
    if (!S.next(0, cur)) return;
    f32x4 acc[2][2][4][2];
#pragma unroll
    for (int a = 0; a < 2; ++a)
#pragma unroll
        for (int b = 0; b < 2; ++b)
#pragma unroll
            for (int m = 0; m < 4; ++m)
#pragma unroll
                for (int n = 0; n < 2; ++n) acc[a][b][m][n] = (f32x4){0.f, 0.f, 0.f, 0.f};
    bf16x8 At[4][2], B0[2][2], B1[2][2];
    const char* cA = PG8_ABASE(cur); const char* cB = PG8_BBASE(cur);
    PG8_STAGE(PG8_SB(0, 0), cB, voffB); PG8_STAGE(PG8_SB(0, 1), cB + hstepB, voffB); PG8_STAGE(PG8_SA(0, 0), cA, voffA); PG8_STAGE(PG8_SA(0, 1), cA + hstepA, voffA);
    if (wr == 1) PG8_BAR;
    PG8_WAIT_V(2); PG8_BAR;
    PG8_STAGE(PG8_SB(1, 0), cB + kstep, voffB); PG8_STAGE(PG8_SA(1, 0), cA + kstep, voffA); PG8_STAGE(PG8_SB(1, 1), cB + hstepB + kstep, voffB);
    PG8_WAIT_V(6); PG8_BAR;
    for (;;) {
        const bool has_next = S.next(ui + 1, nxt);
        const char* nA = has_next ? PG8_ABASE(nxt) : cA; const char* nB = has_next ? PG8_BBASE(nxt) : cB;
        for (int t = 0; t < nt; t += 2) {
            const bool last = (t == nt - 2);
            const char* a1 = cA + (size_t)(t + 1) * kstep;
            const char* a2 = last ? nA : cA + (size_t)(t + 2) * kstep; const char* b2 = last ? nB : cB + (size_t)(t + 2) * kstep;
            const char* a3 = a2 + kstep; const char* b3 = b2 + kstep;
            PG8_LDB(B0, 0, 0); PG8_LDB(B1, 0, 1); PG8_SCHED; PG8_LDA(At, 0, 0); PG8_STAGE(PG8_SA(1, 1), a1 + hstepA, voffA);
            PG8_WAIT_V(8); PG8_WAIT_L(0); PG8_BAR; PG8_MMA(0, 0, At, B0); PG8_MMA(0, 1, At, B1); PG8_BAR; PG8_SCHED;
            PG8_LDA(At, 0, 1); PG8_STAGE(PG8_SB(0, 0), b2, voffB); PG8_STAGE(PG8_SB(0, 1), b2 + hstepB, voffB); PG8_STAGE(PG8_SA(0, 0), a2, voffA);
            PG8_WAIT_V(8); PG8_WAIT_L(0); PG8_BAR; PG8_MMA(1, 0, At, B0); PG8_MMA(1, 1, At, B1); PG8_BAR; PG8_SCHED;
            PG8_LDB(B0, 1, 0); PG8_LDB(B1, 1, 1); PG8_SCHED; PG8_LDA(At, 1, 0); PG8_STAGE(PG8_SA(0, 1), a2 + hstepA, voffA);
            PG8_WAIT_V(8); PG8_WAIT_L(0); PG8_BAR; PG8_MMA(0, 0, At, B0); PG8_MMA(0, 1, At, B1); PG8_BAR; PG8_SCHED;
            PG8_LDA(At, 1, 1); PG8_STAGE(PG8_SB(1, 0), b3, voffB); PG8_STAGE(PG8_SB(1, 1), b3 + hstepB, voffB); PG8_STAGE(PG8_SA(1, 0), a3, voffA);
            PG8_WAIT_V(8); PG8_WAIT_L(0); PG8_BAR; PG8_MMA(1, 0, At, B0); PG8_MMA(1, 1, At, B1); PG8_BAR; PG8_SCHED;
        }
        if (wr == 0) PG8_BAR;
        asm volatile("s_nop 15\n\ts_nop 7" ::: "memory");
        const bool keep = E(acc, cur, wr, wc, fr, fq);
        if (!has_next) break;
        if (!keep)
#pragma unroll
        for (int a = 0; a < 2; ++a)
#pragma unroll
            for (int b = 0; b < 2; ++b)
#pragma unroll
                for (int m = 0; m < 4; ++m)
#pragma unroll
                    for (int n = 0; n < 2; ++n) acc[a][b][m][n] = (f32x4){0.f, 0.f, 0.f, 0.f};
        cur = nxt; cA = nA; cB = nB; ++ui;
        if (wr == 1) PG8_BAR;
    }
    PG8_WAIT_V(0);
    PG8_BAR;
#undef PG8_SA
#undef PG8_SB
#undef PG8_STAGE
#undef PG8_LDA
#undef PG8_LDB
#undef PG8_MMA
#undef PG8_WAIT_V
#undef PG8_WAIT_L
#undef PG8_BAR
#undef PG8_SCHED
#undef PG8_ABASE
#undef PG8_BBASE
}
}

using pg8::bf16_t; using pg8::f32x4; using pg8::u32x4; using pg8::Unit;
typedef unsigned u32x2 __attribute__((ext_vector_type(2)));

constexpr int DM = 2048, NBATCH = 4, SEQ = 4096, MLAT = NBATCH * SEQ, CTXL = 256, MCTX = NBATCH * CTXL, MTOT = MLAT + MCTX;
constexpr int DFF = 5632, NIN = 12352, NINP = 12544, NXBC = 4096;
constexpr float EPS = 1e-6f;
constexpr int LDS_BYTES = 157696 + 16;

constexpr size_t OFF_MOD = 0;
constexpr size_t OFF_BAR = 245760;
constexpr size_t OFF_ROWSS = 262144;
constexpr size_t OFF_DT = 327680;
constexpr size_t OFF_XC = OFF_DT + (size_t)MTOT * 64 * 4;
constexpr size_t OFF_WUP = OFF_XC + (size_t)MCTX * 4096 * 2;
constexpr size_t OFF_WDN = OFF_WUP + (size_t)2 * DFF * DM * 2;
constexpr size_t OFF_WSSD = OFF_WDN + (size_t)DM * DFF * 2;
constexpr size_t OFF_WPO = OFF_WSSD + (size_t)DM * DM * 2;
constexpr size_t OFF_WO = OFF_WPO + (size_t)DM * DM * 2;
constexpr size_t OFF_WPW = OFF_WO + (size_t)DM * DM * 2;
constexpr size_t OFF_XBC = OFF_WPW + (size_t)2048 * 512 * 2;
constexpr size_t SZ_ACT = (size_t)MLAT * DM * 2;
constexpr size_t OFF_Z = OFF_XBC + (size_t)MTOT * 4096 * 2;
constexpr size_t OFF_V = OFF_Z + SZ_ACT;
constexpr size_t OFF_GS = OFF_V + SZ_ACT;
constexpr size_t OFF_GP = OFF_GS + SZ_ACT;
constexpr size_t OFF_WFOLD = OFF_GP + SZ_ACT;
constexpr size_t OFF_BIAS2 = OFF_WFOLD + (size_t)DM * DM * 2;
constexpr size_t WS_END = OFF_BIAS2 + (size_t)4 * 2 * DFF * 4;
constexpr size_t OFF_P = OFF_V;
constexpr size_t OFF_YF = OFF_XBC + SZ_ACT, OFF_YB = OFF_XBC, OFF_YS = OFF_Z, OFF_T1 = OFF_V, OFF_MG = OFF_XBC, OFF_H2 = OFF_GP;
constexpr size_t OFF_UPA = OFF_WSSD;
constexpr size_t OFF_UPG = OFF_UPA + (size_t)MLAT * DFF * 2;
static_assert(OFF_UPG + (size_t)MLAT * DFF * 2 <= OFF_H2, "up buffers overlap h2");
constexpr size_t OUT_HN = 0;
constexpr size_t OUT_WINT = (size_t)MTOT * DM * 2;
static_assert(OUT_WINT + (size_t)NINP * DM * 2 <= (size_t)MLAT * DM * 4, "d_out overlay");

struct Params { const float* in[25]; float* out; unsigned char* ws; int ph_lo, ph_hi; };

__device__ __forceinline__ float bflo(unsigned u) { return __uint_as_float(u << 16); }
__device__ __forceinline__ float bfhi(unsigned u) { return __uint_as_float(u & 0xffff0000u); }
__device__ __forceinline__ unsigned pk2(float lo, float hi) { return pg8::cvt_pk_bf16(lo, hi); }
__device__ __forceinline__ void unpack8(const u32x4 r, float (&o)[8]) { o[0] = bflo(r.x); o[1] = bfhi(r.x); o[2] = bflo(r.y); o[3] = bfhi(r.y); o[4] = bflo(r.z); o[5] = bfhi(r.z); o[6] = bflo(r.w); o[7] = bfhi(r.w); }
__device__ __forceinline__ u32x4 pack8(const float (&o)[8]) { u32x4 r; r.x = pk2(o[0], o[1]); r.y = pk2(o[2], o[3]); r.z = pk2(o[4], o[5]); r.w = pk2(o[6], o[7]); return r; }
typedef _Float16 h16x2 __attribute__((ext_vector_type(2)));
__device__ __forceinline__ unsigned pkh2(float lo, float hi) { h16x2 v; v.x = (_Float16)lo; v.y = (_Float16)hi; return __builtin_bit_cast(unsigned, v); }
__device__ __forceinline__ u32x4 packh44(const f32x4 a, const f32x4 b) { u32x4 w; w.x = pkh2(a[0], a[1]); w.y = pkh2(a[2], a[3]); w.z = pkh2(b[0], b[1]); w.w = pkh2(b[2], b[3]); return w; }
__device__ __forceinline__ void unpackh44(const u32x4 r, f32x4& a, f32x4& b) {
    const unsigned r0 = r.x, r1 = r.y, r2 = r.z, r3 = r.w;
    const h16x2 p0 = __builtin_bit_cast(h16x2, r0), p1 = __builtin_bit_cast(h16x2, r1), p2 = __builtin_bit_cast(h16x2, r2), p3 = __builtin_bit_cast(h16x2, r3);
    a = (f32x4){(float)p0.x, (float)p0.y, (float)p1.x, (float)p1.y}; b = (f32x4){(float)p2.x, (float)p2.y, (float)p3.x, (float)p3.y}; }
__device__ __forceinline__ float wave_sum(float v) {
#pragma unroll
    for (int o = 1; o < 64; o <<= 1) v += __shfl_xor(v, o);
    return v;
}
__device__ __forceinline__ float wave_incl_scan(float x) {
#define DPP_ADD(ctrl_, rmask_) x += __int_as_float(__builtin_amdgcn_update_dpp(0, __float_as_int(x), ctrl_, rmask_, 0xf, false))
    DPP_ADD(0x111, 0xf); DPP_ADD(0x112, 0xf); DPP_ADD(0x114, 0xf); DPP_ADD(0x118, 0xf); DPP_ADD(0x142, 0xa); DPP_ADD(0x143, 0xc);
#undef DPP_ADD
    return x;
}
__device__ __forceinline__ float sigmoidf_(float x) { return __builtin_amdgcn_rcpf(1.0f + __expf(-x)); }
__device__ __forceinline__ float siluf_(float x) { return x * __builtin_amdgcn_rcpf(1.0f + __expf(-x)); }
typedef float f32x2 __attribute__((ext_vector_type(2)));
__device__ __forceinline__ f32x2 gelu_pk(f32x2 v) {
    const f32x2 av = __builtin_elementwise_abs(v), d = av * 0.2316418882f + 1.0f;
    f32x2 t; t.x = __builtin_amdgcn_rcpf(d.x); t.y = __builtin_amdgcn_rcpf(d.y);
    f32x2 q = t * 0.5307027145f + (-0.7265760135f); q = q * t + 0.7107068705f; q = q * t + (-0.142248368f); q = q * t + 0.127414796f; q = q * t;
    const f32x2 s = (v * v) * (-0.72134752044f);
    f32x2 e; e.x = __builtin_amdgcn_exp2f(s.x); e.y = __builtin_amdgcn_exp2f(s.y);
    const f32x2 m = v * (q * e), r = v - m;
    f32x2 o; o.x = v.x < 0.f ? m.x : r.x; o.y = v.y < 0.f ? m.y : r.y; return o;
}
__device__ __forceinline__ float softplusf_(float x) { return fmaxf(x, 0.f) + log1pf(__expf(-fabsf(x))); }
__device__ __forceinline__ void load8f(const float* p, float (&o)[8]) { const f32x4 a = *(const f32x4*)p, b = *(const f32x4*)(p + 4); o[0] = a.x; o[1] = a.y; o[2] = a.z; o[3] = a.w; o[4] = b.x; o[5] = b.y; o[6] = b.z; o[7] = b.w; }

#define EPI_LOOP_BEGIN \
    const int row0 = u.pm * 256 + wr * 64 + fr, cl0 = wc * 32 + 8 * fq; \
    _Pragma("unroll") for (int ai = 0; ai < 2; ++ai) _Pragma("unroll") for (int m = 0; m < 4; ++m) { const int row = row0 + ai * 128 + m * 16; \
    _Pragma("unroll") for (int bj = 0; bj < 2; ++bj) { const int cl = cl0 + bj * 128; const f32x4 v0 = acc[ai][bj][m][0], v1 = acc[ai][bj][m][1];
#define EPI_LOOP_END } }
__device__ __forceinline__ u32x4 pack44(const f32x4 a, const f32x4 b) { u32x4 w; w.x = pk2(a[0], a[1]); w.y = pk2(a[2], a[3]); w.z = pk2(b[0], b[1]); w.w = pk2(b[2], b[3]); return w; }

struct EpiProj {
    bf16_t* xbc; bf16_t* zvg; float* dt; const float* dt_bias;
    __device__ __forceinline__ bool operator()(f32x4 (&acc)[2][2][4][2], const Unit& u, int wr, int wc, int fr, int fq) const {
        if (u.pn < 16) {
            EPI_LOOP_BEGIN *(u32x4*)(xbc + (size_t)row * 4096 + u.pn * 256 + cl) = pack44(v0, v1); EPI_LOOP_END
        } else if (u.pn < 48) {
            bf16_t* base = zvg + (size_t)((u.pn - 16) >> 3) * ((size_t)MLAT * DM) + ((u.pn - 16) & 7) * 256;
            EPI_LOOP_BEGIN *(u32x4*)(base + (size_t)row * DM + cl) = pack44(v0, v1); EPI_LOOP_END
        } else {
            EPI_LOOP_BEGIN
                if (cl < 64) { const f32x4 b0 = *(const f32x4*)(dt_bias + cl), b1 = *(const f32x4*)(dt_bias + cl + 4); f32x4 o0, o1;
#pragma unroll
                    for (int e = 0; e < 4; ++e) { o0[e] = softplusf_(v0[e] + b0[e]); o1[e] = softplusf_(v1[e] + b1[e]); }
                    *(f32x4*)(dt + (size_t)row * 64 + cl) = o0; *(f32x4*)(dt + (size_t)row * 64 + cl + 4) = o1; }
            EPI_LOOP_END
        }
        return false;
    }
};
struct EpiPlain {
    bf16_t* o;
    __device__ __forceinline__ bool operator()(f32x4 (&acc)[2][2][4][2], const Unit& u, int wr, int wc, int fr, int fq) const {
        EPI_LOOP_BEGIN *(u32x4*)(o + (size_t)row * DM + u.pn * 256 + cl) = pack44(v0, v1); EPI_LOOP_END
        return false;
    }
};
struct EpiScale {
    bf16_t* o; const float* scale;
    __device__ __forceinline__ bool operator()(f32x4 (&acc)[2][2][4][2], const Unit& u, int wr, int wc, int fr, int fq) const {
        EPI_LOOP_BEGIN const int col = u.pn * 256 + cl; const f32x4 s0 = *(const f32x4*)(scale + col), s1 = *(const f32x4*)(scale + col + 4);
            *(u32x4*)(o + (size_t)row * DM + col) = pack44(v0 * s0, v1 * s1); EPI_LOOP_END
        return false;
    }
};
template <int SECOND> struct EpiGate {
    bf16_t* o; const bf16_t* gate; const bf16_t* t1;
    __device__ __forceinline__ bool operator()(f32x4 (&acc)[2][2][4][2], const Unit& u, int wr, int wc, int fr, int fq) const {
        EPI_LOOP_BEGIN const size_t off = (size_t)row * DM + u.pn * 256 + cl; float gt[8]; unpack8(*(const u32x4*)(gate + off), gt);
            float r[8];
#pragma unroll
            for (int e = 0; e < 4; ++e) { r[e] = sigmoidf_(gt[e]) * v0[e]; r[4 + e] = sigmoidf_(gt[4 + e]) * v1[e]; }
            if (SECOND) { float pv[8]; unpack8(*(const u32x4*)(t1 + off), pv);
#pragma unroll
                for (int e = 0; e < 8; ++e) r[e] += pv[e]; }
            *(u32x4*)(o + off) = pack8(r); EPI_LOOP_END
        return false;
    }
};
struct EpiGateDual {
    bf16_t* o; const bf16_t* gs; const bf16_t* gp;
    __device__ __forceinline__ bool operator()(f32x4 (&acc)[2][2][4][2], const Unit& u, int wr, int wc, int fr, int fq) const {
        const int row0 = u.pm * 256 + wr * 64 + fr, cl0 = wc * 32 + 8 * fq;
        if (u.half == 0) {
#pragma unroll
            for (int ai = 0; ai < 2; ++ai)
#pragma unroll
                for (int m = 0; m < 4; ++m)
#pragma unroll
                    for (int bj = 0; bj < 2; ++bj) { const size_t off = (size_t)(row0 + ai * 128 + m * 16) * DM + u.pn * 256 + cl0 + bj * 128;
                        float a[8], b[8]; unpack8(*(const u32x4*)(gs + off), a); unpack8(*(const u32x4*)(gp + off), b);
#pragma unroll
                        for (int e = 0; e < 4; ++e) { acc[ai][bj][m][0][e] *= (1.0f + __expf(-b[e])) * __builtin_amdgcn_rcpf(1.0f + __expf(-a[e]));
                                                      acc[ai][bj][m][1][e] *= (1.0f + __expf(-b[4 + e])) * __builtin_amdgcn_rcpf(1.0f + __expf(-a[4 + e])); } }
            return true;
        }
#pragma unroll
        for (int ai = 0; ai < 2; ++ai)
#pragma unroll
            for (int m = 0; m < 4; ++m)
#pragma unroll
                for (int bj = 0; bj < 2; ++bj) { const size_t off = (size_t)(row0 + ai * 128 + m * 16) * DM + u.pn * 256 + cl0 + bj * 128;
                    float b[8], r[8]; unpack8(*(const u32x4*)(gp + off), b);
#pragma unroll
                    for (int e = 0; e < 4; ++e) { r[e] = acc[ai][bj][m][0][e] * sigmoidf_(b[e]); r[4 + e] = acc[ai][bj][m][1][e] * sigmoidf_(b[4 + e]); }
                    *(u32x4*)(o + off) = pack8(r); }
        return false;
    }
};
struct EpiRes {
    unsigned short* o; const unsigned short* base; const float* gate;
    __device__ __forceinline__ bool operator()(f32x4 (&acc)[2][2][4][2], const Unit& u, int wr, int wc, int fr, int fq) const {
        EPI_LOOP_BEGIN const int col = u.pn * 256 + cl; const size_t off = (size_t)row * DM + col; const float* gp = gate + (size_t)(row >> 12) * 12288 + col;
            const f32x4 g0 = *(const f32x4*)gp, g1 = *(const f32x4*)(gp + 4); f32x4 x0, x1; unpackh44(*(const u32x4*)(base + off), x0, x1);
            *(u32x4*)(o + off) = packh44(x0 + g0 * v0, x1 + g1 * v1); EPI_LOOP_END
        return false;
    }
};
struct EpiRes1 {
    unsigned short* o; const float* base; const float* mod; const float* n2w; bf16_t* xm; float* rowss;
    __device__ __forceinline__ bool operator()(f32x4 (&acc)[2][2][4][2], const Unit& u, int wr, int wc, int fr, int fq) const {
        const int row0 = u.pm * 256 + wr * 64 + fr, cl0 = wc * 32 + 8 * fq; const float* mr = mod + (size_t)(row0 >> 12) * 12288;
#pragma unroll
        for (int ai = 0; ai < 2; ++ai)
#pragma unroll
            for (int m = 0; m < 4; ++m) { const int row = row0 + ai * 128 + m * 16; float ss = 0.f;
#pragma unroll
                for (int bj = 0; bj < 2; ++bj) { const int col = u.pn * 256 + cl0 + bj * 128; const size_t off = (size_t)row * DM + col;
                    const f32x4 g0 = *(const f32x4*)(mr + 2 * DM + col), g1 = *(const f32x4*)(mr + 2 * DM + col + 4), x0 = *(const f32x4*)(base + off), x1 = *(const f32x4*)(base + off + 4);
                    const f32x4 r0 = x0 + g0 * acc[ai][bj][m][0], r1 = x1 + g1 * acc[ai][bj][m][1];
                    *(u32x4*)(o + off) = packh44(r0, r1);
                    ss += (r0.x * r0.x + r0.y * r0.y) + (r0.z * r0.z + r0.w * r0.w) + (r1.x * r1.x + r1.y * r1.y) + (r1.z * r1.z + r1.w * r1.w);
                    const f32x4 w0 = *(const f32x4*)(n2w + col) * (*(const f32x4*)(mr + 4 * DM + col) + 1.0f), w1 = *(const f32x4*)(n2w + col + 4) * (*(const f32x4*)(mr + 4 * DM + col + 4) + 1.0f);
                    *(u32x4*)(xm + off) = pack44(r0 * w0, r1 * w1); }
                ss += __shfl_xor(ss, 16); ss += __shfl_xor(ss, 32);
                if (fq == 0) atomicAdd(rowss + row, ss); }
        return false;
    }
};
struct EpiUp {
    bf16_t* a; bf16_t* g; const float* rowss; const float* bias2;
    __device__ __forceinline__ bool operator()(f32x4 (&acc)[2][2][4][2], const Unit& u, int wr, int wc, int fr, int fq) const {
        bf16_t* base = (u.pn < 22) ? a + u.pn * 256 : g + (u.pn - 22) * 256;
        const int row0 = u.pm * 256 + wr * 64 + fr, cl0 = wc * 32 + 8 * fq; const float* bb = bias2 + (size_t)(row0 >> 12) * (2 * DFF) + u.pn * 256 + cl0;
        const f32x4 b00 = *(const f32x4*)bb, b01 = *(const f32x4*)(bb + 4), b10 = *(const f32x4*)(bb + 128), b11 = *(const f32x4*)(bb + 132);
#pragma unroll
        for (int ai = 0; ai < 2; ++ai)
#pragma unroll
            for (int m = 0; m < 4; ++m) { const int row = row0 + ai * 128 + m * 16; const float rstd = rsqrtf(rowss[row] * (1.0f / DM) + EPS);
                *(u32x4*)(base + (size_t)row * DFF + cl0) = pack44(acc[ai][0][m][0] * rstd + b00, acc[ai][0][m][1] * rstd + b01);
                *(u32x4*)(base + (size_t)row * DFF + cl0 + 128) = pack44(acc[ai][1][m][0] * rstd + b10, acc[ai][1][m][1] * rstd + b11); }
        return false;
    }
};

#define LDS_WAIT() asm volatile("s_waitcnt lgkmcnt(0)" ::: "memory")

__device__ __forceinline__ void transpose_item(const float* W, int N, int k0, int n0, bf16_t* WT, int ldt, int dst_row0, float* scr, int lane) {
    float tv[32];
#pragma unroll
    for (int i = 0; i < 32; ++i) tv[i] = W[(size_t)(k0 + 2 * i + (lane >> 5)) * N + n0 + (lane & 31)];
#pragma unroll
    for (int i = 0; i < 32; ++i) scr[(2 * i + (lane >> 5)) * 33 + (lane & 31)] = tv[i];
    LDS_WAIT();
    const int c = lane & 7;
#pragma unroll
    for (int j = 0; j < 4; ++j) { const int n = (lane >> 3) + 8 * j; const float* s = scr + (8 * c) * 33 + n;
        u32x4 o; o.x = pk2(s[0 * 33], s[1 * 33]); o.y = pk2(s[2 * 33], s[3 * 33]); o.z = pk2(s[4 * 33], s[5 * 33]); o.w = pk2(s[6 * 33], s[7 * 33]);
        *(u32x4*)(WT + (size_t)(dst_row0 + n) * ldt + k0 + 8 * c) = o; }
    LDS_WAIT();
}

__device__ __forceinline__ void phase_prologue(const Params& p, unsigned char* smem) {
    const int tid = threadIdx.x, lane = tid & 63, wave = tid >> 6;
    const int gtid = blockIdx.x * 512 + tid, NT = gridDim.x * 512;
    float* sc = (float*)smem;
    for (int i = tid; i < 5 * DM; i += 512) { const int r = i >> 11, k = i & 2047; const float v = (r < 4) ? p.in[1][r * DM + k] : p.in[3][k]; sc[i] = v / (1.0f + expf(-v)); }
    __syncthreads();
    float* mod = (float*)(p.ws + OFF_MOD);
    for (int task = gtid; task < 3072 * 42; task += NT) {
        const int cq = task % 3072, ks = task / 3072, k0 = ks * 49, kn = min(49, DM - k0);
        f32x4 a0 = {0.f, 0.f, 0.f, 0.f}, a1 = a0, a2 = a0, a3 = a0, a4 = a0;
        const float* wp = p.in[4] + (size_t)k0 * 12288 + cq * 4;
#pragma unroll 7
        for (int kk = 0; kk < kn; ++kk) { const f32x4 w = *(const f32x4*)(wp + (size_t)kk * 12288); const int k = k0 + kk;
            a0 += sc[k] * w; a1 += sc[DM + k] * w; a2 += sc[2 * DM + k] * w; a3 += sc[3 * DM + k] * w; a4 += sc[4 * DM + k] * w; }
        if (ks == 0) { const f32x4 b = *(const f32x4*)(p.in[5] + cq * 4); a0 += b; a1 += b; a2 += b; a3 += b; a4 += b; }
#pragma unroll
        for (int e = 0; e < 4; ++e) { atomicAdd(mod + 0 * 12288 + cq * 4 + e, a0[e]); atomicAdd(mod + 1 * 12288 + cq * 4 + e, a1[e]); atomicAdd(mod + 2 * 12288 + cq * 4 + e, a2[e]);
            atomicAdd(mod + 3 * 12288 + cq * 4 + e, a3[e]); atomicAdd(mod + 4 * 12288 + cq * 4 + e, a4[e]); }
    }
    __syncthreads();
    float* scr = (float*)smem + wave * (64 * 33);
    bf16_t* WINT = (bf16_t*)((unsigned char*)p.out + OUT_WINT);
    const int gw = blockIdx.x * 8 + wave, NGW = gridDim.x * 8;
    constexpr int I_IN = 32 * (NIN / 32), I_SQ = 32 * 64, I_UP = 32 * (2 * DFF / 32), I_DN = (DFF / 64) * 64;
    constexpr int NITEMS = I_IN + 2 * I_SQ + I_UP;
    (void)I_DN;
    for (int it = gw; it < NITEMS; it += NGW) {
        int r = it;
        if (r < I_IN) { const int nblk = NIN / 32, kb = r / nblk, nb = r % nblk, n0 = 32 * nb; const int drow = (n0 >= 64) ? n0 - 64 : 12288 + n0;
            transpose_item(p.in[7], NIN, 64 * kb, n0, WINT, DM, drow, scr, lane); continue; } r -= I_IN;
        if (r < I_SQ) { transpose_item(p.in[17], DM, 64 * (r / 64), 32 * (r % 64), (bf16_t*)(p.ws + OFF_WPO), DM, 32 * (r % 64), scr, lane); continue; } r -= I_SQ;
        if (r < I_SQ) { transpose_item(p.in[14], DM, 64 * (r / 64), 32 * (r % 64), (bf16_t*)(p.ws + OFF_WSSD), DM, 32 * (r % 64), scr, lane); continue; } r -= I_SQ;
        { const int nblk = 2 * DFF / 32; transpose_item(p.in[20], 2 * DFF, 64 * (r / nblk), 32 * (r % nblk), (bf16_t*)(p.ws + OFF_WUP), DM, 32 * (r % nblk), scr, lane); }
    }
    for (int i = gtid; i < 2048 * 64; i += NT) { const int row = i >> 6, o8 = (i & 63) * 8; float w[8], s[8], o[8]; load8f(p.in[15] + (size_t)row * 512 + o8, w); load8f(p.in[16] + (row >> 9) * 512 + o8, s);
#pragma unroll
        for (int e = 0; e < 8; ++e) o[e] = w[e] * s[e];
        *(u32x4*)((bf16_t*)(p.ws + OFF_WPW) + (size_t)row * 512 + o8) = pack8(o); }
    { u32x4* z = (u32x4*)(WINT + (size_t)NIN * DM); const u32x4 zero = {0u, 0u, 0u, 0u};
      for (int i = gtid; i < (NINP - NIN) * DM / 8; i += NT) z[i] = zero; }
}

__device__ __forceinline__ void phase_late_weights(const Params& p, unsigned char* smem, int widx, int nw) {
    const int lane = threadIdx.x & 63, wave = threadIdx.x >> 6;
    float* scr = (float*)smem + wave * (64 * 33);
    constexpr int I_SQ = 32 * 64, I_DN = (DFF / 64) * 64;
    for (int it = widx * 8 + wave; it < I_SQ + I_DN; it += nw * 8) {
        int r = it;
        if (r < I_SQ) { transpose_item(p.in[18], DM, 64 * (r / 64), 32 * (r % 64), (bf16_t*)(p.ws + OFF_WO), DM, 32 * (r % 64), scr, lane); continue; } r -= I_SQ;
        { transpose_item(p.in[23], DM, 64 * (r / 64), 32 * (r % 64), (bf16_t*)(p.ws + OFF_WDN), DFF, 32 * (r % 64), scr, lane); }
    }
}

__device__ __forceinline__ void phase_modulate(const float* src_lat, const float* src_ctx, int nrows, const float* normw, const float* mod, int shidx, int scidx, bf16_t* dst) {
    const int lane = threadIdx.x & 63, rpb = (nrows + (int)gridDim.x - 1) / (int)gridDim.x, rend = min(nrows, ((int)blockIdx.x + 1) * rpb), gw = blockIdx.x * rpb + (threadIdx.x >> 6), NGW = 8;
    f32x4 v[8], wsc[8], shv[8]; int cur_mi = -1;
    if (gw < rend) { const float* xr = (gw < MLAT) ? src_lat + (size_t)gw * DM : src_ctx + (size_t)(gw - MLAT) * DM;
#pragma unroll
        for (int j = 0; j < 8; ++j) v[j] = *(const f32x4*)(xr + 4 * (lane + 64 * j)); }
    for (int row = gw; row < rend; row += NGW) {
        f32x4 nv[8]; const int nrow = row + NGW;
        if (nrow < rend) { const float* xr = (nrow < MLAT) ? src_lat + (size_t)nrow * DM : src_ctx + (size_t)(nrow - MLAT) * DM;
#pragma unroll
            for (int j = 0; j < 8; ++j) nv[j] = *(const f32x4*)(xr + 4 * (lane + 64 * j)); }
        const int mi = (row < MLAT) ? (row >> 12) : 4;
        if (mi != cur_mi) { cur_mi = mi; const float* mr = mod + (size_t)mi * 12288;
#pragma unroll
            for (int j = 0; j < 8; ++j) { const int col = 4 * (lane + 64 * j); wsc[j] = *(const f32x4*)(normw + col) * (*(const f32x4*)(mr + scidx * DM + col) + 1.0f); shv[j] = *(const f32x4*)(mr + shidx * DM + col); } }
        float s = 0.f;
#pragma unroll
        for (int j = 0; j < 8; ++j) s += (v[j].x * v[j].x + v[j].y * v[j].y) + (v[j].z * v[j].z + v[j].w * v[j].w);
        const float rstd = rsqrtf(wave_sum(s) * (1.0f / DM) + EPS);
#pragma unroll
        for (int j = 0; j < 8; ++j) { const int col = 4 * (lane + 64 * j);
            const f32x4 o = (v[j] * rstd) * wsc[j] + shv[j];
            u32x2 pk; pk.x = pk2(o.x, o.y); pk.y = pk2(o.z, o.w); *(u32x2*)(dst + (size_t)row * DM + col) = pk; }
        if (nrow < rend) {
#pragma unroll
            for (int j = 0; j < 8; ++j) v[j] = nv[j]; }
    }
}

__device__ __forceinline__ void phase_conv_pool(const Params& p, unsigned char* smem) {
    const int tid = threadIdx.x, gtid = blockIdx.x * 512 + tid, NT = gridDim.x * 512;
    const bf16_t* raw = (const bf16_t*)(p.ws + OFF_XBC); const float* cw = p.in[8]; const float* cb = p.in[9];
    bf16_t* xcl = (bf16_t*)p.out; bf16_t* xcc = (bf16_t*)(p.ws + OFF_XC);
    const u32x4 zero = {0u, 0u, 0u, 0u};
    {
        const int col = tid * 8, tpb = (MLAT + (int)gridDim.x - 1) / (int)gridDim.x, t0 = blockIdx.x * tpb, t1 = min(t0 + tpb, MLAT);
        float w0[8], w1[8], w2[8], bb[8]; load8f(cw + col, w0); load8f(cw + 4096 + col, w1); load8f(cw + 8192 + col, w2); load8f(cb + col, bb);
        if (t0 < t1) {
            const bf16_t* src = raw + (size_t)t0 * 4096 + col; bf16_t* dst = xcl + (size_t)t0 * 4096 + col;
            float x0[8], x1[8];
            unpack8(((t0 & (SEQ - 1)) != 0) ? *(const u32x4*)(src - 4096) : zero, x0); unpack8(*(const u32x4*)src, x1);
#pragma unroll 4
            for (int t = t0; t < t1; ++t) {
                const u32x4 r2 = (((t + 1) & (SEQ - 1)) != 0) ? __builtin_nontemporal_load((const u32x4*)(src + 4096)) : zero;
                float x2[8], o[8]; unpack8(r2, x2);
#pragma unroll
                for (int e = 0; e < 8; ++e) o[e] = siluf_(x0[e] * w0[e] + bb[e] + x1[e] * w1[e] + x2[e] * w2[e]);
                *(u32x4*)dst = pack8(o);
#pragma unroll
                for (int e = 0; e < 8; ++e) { x0[e] = x1[e]; x1[e] = x2[e]; }
                src += 4096; dst += 4096;
            }
        }
    }
    for (int idx = gtid; idx < MCTX * 384; idx += NT) {
        const int t = idx / 384, col = (idx % 384) * 8, tl = t & (CTXL - 1); const bf16_t* src = raw + (size_t)(MLAT + t) * 4096 + col; bf16_t* dst = xcc + (size_t)t * 4096 + col;
        const u32x4 r1 = *(const u32x4*)src; const u32x4 r0 = (tl > 0) ? *(const u32x4*)(src - 4096) : zero; const u32x4 r2 = (tl < CTXL - 1) ? *(const u32x4*)(src + 4096) : zero;
        float x0[8], x1[8], x2[8], w0[8], w1[8], w2[8], b[8], o[8];
        unpack8(r0, x0); unpack8(r1, x1); unpack8(r2, x2); load8f(cw + col, w0); load8f(cw + 4096 + col, w1); load8f(cw + 8192 + col, w2); load8f(cb + col, b);
#pragma unroll
        for (int e = 0; e < 8; ++e) o[e] = siluf_(x0[e] * w0[e] + b[e] + x1[e] * w1[e] + x2[e] * w2[e]);
        *(u32x4*)dst = pack8(o);
    }
    const bf16_t* V = (const bf16_t*)(p.ws + OFF_V); bf16_t* P = (bf16_t*)(p.ws + OFF_P);
    PG8_LAS unsigned char* L = (PG8_LAS unsigned char*)smem;
    for (int it = blockIdx.x; it < (MLAT / 64) * 4; it += gridDim.x) {
        const int gr = it >> 2, g = it & 3, hw = 1 << g;
        const bf16_t* base = V + (size_t)gr * 64 * DM + g * 512;
        __syncthreads();
#pragma unroll
        for (int j = 0; j < 8; ++j) { const int piece = tid + 512 * j, row = piece >> 6, pc = piece & 63; *(PG8_LAS u32x4*)(L + row * 1024 + pc * 16) = *(const u32x4*)(base + (size_t)row * DM + pc * 8); }
        __syncthreads();
        const int cvv = tid & 63, tq = tid >> 6;
        float s[8];
#pragma unroll
        for (int e = 0; e < 8; ++e) s[e] = 0.f;
        for (int jj = max(tq * 8 - hw, 0); jj < min(tq * 8 + hw, 64); ++jj) { float x[8]; unpack8(*(const PG8_LAS u32x4*)(L + jj * 1024 + cvv * 16), x);
#pragma unroll
            for (int e = 0; e < 8; ++e) s[e] += x[e]; }
        for (int i = 0; i < 8; ++i) { const int tc = tq * 8 + i, lo = max(tc - hw, 0), hi = min(tc + hw, 64);
            float me[8], o[8];
            if (i > 0) {
                const int ad = tc - 1 + hw, sb = tc - 1 - hw;
                if (ad < 64) { float x[8]; unpack8(*(const PG8_LAS u32x4*)(L + ad * 1024 + cvv * 16), x);
#pragma unroll
                    for (int e = 0; e < 8; ++e) s[e] += x[e]; }
                if (sb >= 0) { float x[8]; unpack8(*(const PG8_LAS u32x4*)(L + sb * 1024 + cvv * 16), x);
#pragma unroll
                    for (int e = 0; e < 8; ++e) s[e] -= x[e]; }
            }
            unpack8(*(const PG8_LAS u32x4*)(L + tc * 1024 + cvv * 16), me);
            const float inv = 1.0f / (float)(hi - lo);
#pragma unroll
            for (int e = 0; e < 8; ++e) o[e] = s[e] * inv - me[e];
            *(u32x4*)(P + (size_t)(gr * 64 + tc) * DM + g * 512 + cvv * 8) = pack8(o); }
    }
}

__device__ __forceinline__ void phase_ssd_scan(const Params& p, unsigned char* smem) {
    const int tid = threadIdx.x, lane = tid & 63, wave = tid >> 6;
    float* sX = (float*)smem;
    float* sB = sX + 32 * 64;
    float* sC = sB + 32 * 128;
    float* sY = sC + 32 * 128;
    float* sdt = sY + 8 * 32 * 64;
    const bf16_t* xcl = (const bf16_t*)p.out; const bf16_t* xcc = (const bf16_t*)(p.ws + OFF_XC); const float* DT = (const float*)(p.ws + OFF_DT);
    for (int item = blockIdx.x; item < 256; item += gridDim.x) {
        const int xcd = item & 7, slot = item >> 3, gid = xcd * 4 + (slot >> 3), mem = slot & 7;
        const int b = gid >> 3, g = gid & 7, dir = mem >> 2, h = g * 4 + (mem & 3);
        const float Ah = -expf(p.in[11][dir * 32 + h]), dsk = p.in[12][dir * 32 + h];
        bf16_t* Y = (bf16_t*)(p.ws + (dir ? OFF_YB : OFF_YF));
        float hs[16];
#pragma unroll
        for (int j = 0; j < 16; ++j) hs[j] = 0.f;
        for (int ck = 0; ck < (CTXL + SEQ) / 32; ++ck) {
            const bool isctx = ck < CTXL / 32;
            __syncthreads();
            {   const int i = tid >> 4, q = tid & 15;
                const int s = ck * 32 + i;
                int tok; const bf16_t* rowp; size_t drow;
                if (isctx) { tok = dir ? (CTXL - 1 - s) : s; rowp = xcc + (size_t)(b * CTXL + tok) * 4096; drow = (size_t)(MLAT + b * CTXL + tok); }
                else { const int s2 = s - CTXL; tok = dir ? (SEQ - 1 - s2) : s2; rowp = xcl + (size_t)(b * SEQ + tok) * 4096; drow = (size_t)(b * SEQ + tok); }
                { const u32x2 xv = *(const u32x2*)(rowp + h * 64 + q * 4); float* d = sX + i * 64 + q * 4; d[0] = bflo(xv.x); d[1] = bfhi(xv.x); d[2] = bflo(xv.y); d[3] = bfhi(xv.y); }
                { float o[8]; unpack8(*(const u32x4*)(rowp + 2048 + g * 128 + q * 8), o); float* d = sB + i * 128 + q * 8;
#pragma unroll
                  for (int e = 0; e < 8; ++e) d[e] = o[e]; }
                if (!isctx) { float o[8]; unpack8(*(const u32x4*)(rowp + 3072 + g * 128 + q * 8), o); float* d = sC + i * 128 + q * 8;
#pragma unroll
                  for (int e = 0; e < 8; ++e) d[e] = o[e]; }
                if (q == 0) { const float dt = DT[drow * 64 + dir * 32 + h]; sdt[i] = dt; sdt[32 + i] = expf(dt * Ah); }
            }
            __syncthreads();
            for (int i = 0; i < 32; ++i) {
                const float dt = sdt[i], dA = sdt[32 + i], xd = sX[i * 64 + lane] * dt;
                const float* bp = sB + i * 128 + wave * 16; const float* cp = sC + i * 128 + wave * 16;
                float yp = 0.f;
#pragma unroll
                for (int j = 0; j < 16; ++j) { hs[j] = hs[j] * dA + xd * bp[j]; yp += cp[j] * hs[j]; }
                sY[(wave * 32 + i) * 64 + lane] = yp;
            }
            __syncthreads();
            if (!isctx) {
                const int i = tid >> 4, q = tid & 15, s2 = ck * 32 + i - CTXL, tok = dir ? (SEQ - 1 - s2) : s2;
                float o[4];
#pragma unroll
                for (int e = 0; e < 4; ++e) { const int pp = q * 4 + e; float a = dsk * sX[i * 64 + pp];
#pragma unroll
                    for (int w = 0; w < 8; ++w) a += sY[(w * 32 + i) * 64 + pp];
                    o[e] = a; }
                u32x2 pk; pk.x = pk2(o[0], o[1]); pk.y = pk2(o[2], o[3]);
                *(u32x2*)(Y + (size_t)(b * SEQ + tok) * DM + h * 64 + q * 4) = pk;
            }
        }
    }
}


constexpr int SS_LD = 272;
constexpr int SS_C = 0, SS_B = 34816, SS_BT = 69632, SS_XT = 104448, SS_HB = 121856, SS_CS = 139264, SS_DT = 139776, SS_HB2 = 140288, SS_END = 157696;
__device__ __forceinline__ void phase_ssd_mfma(const Params& p, unsigned char* smem) {
    using pg8::bf16x8;
    const int tid = threadIdx.x, lane = tid & 63, wave = __builtin_amdgcn_readfirstlane(tid >> 6), fr = lane & 15, fq = lane >> 4;
    PG8_LAS unsigned char* L = (PG8_LAS unsigned char*)smem;
    PG8_LAS float* scs = (PG8_LAS float*)(L + SS_CS); PG8_LAS float* sdt = (PG8_LAS float*)(L + SS_DT);
    const bf16_t* xcl = (const bf16_t*)p.out; const bf16_t* xcc = (const bf16_t*)(p.ws + OFF_XC); const float* DT = (const float*)(p.ws + OFF_DT);
#define SSD_ROW(s_, rowp_, drow_) do { if (isctx) { const int tk_ = dir ? (CTXL - 1 - (sbase + (s_))) : (sbase + (s_)); const int gr_ = b * CTXL + tk_; rowp_ = xcc + (size_t)gr_ * 4096; drow_ = MLAT + gr_; } \
        else { const int tk_ = dir ? (SEQ - 1 - (sbase + (s_))) : (sbase + (s_)); const int gr_ = b * SEQ + tk_; rowp_ = xcl + (size_t)gr_ * 4096; drow_ = gr_; } } while (0)
#define SSD_FRAG(off_, row_, ks_) (*(const PG8_LAS bf16x8*)(L + (off_) + (row_) * SS_LD + (ks_) * 64 + fq * 16))
    for (int item = blockIdx.x; item < 256; item += gridDim.x) {
        const int xcd = item & 7, slot = item >> 3, gid = xcd * 4 + (slot >> 3), mem = slot & 7;
        const int b = gid >> 3, g = gid & 7, dir = mem >> 2, h = g * 4 + (mem & 3);
        const float Ah = -expf(p.in[11][dir * 32 + h]), dsk = p.in[12][dir * 32 + h];
        bf16_t* Y = (bf16_t*)(p.ws + (dir ? OFF_YB : OFF_YF));
        f32x4 H[4];
#pragma unroll
        for (int j = 0; j < 4; ++j) H[j] = (f32x4){0.f, 0.f, 0.f, 0.f};
        const int hi_half = wave & 1, sm = lane + 64 * hi_half, q4 = wave >> 1;
        float dt_lo, dt_hi; u32x4 xv[2], bv[4], cv[4];
#define SSD_LOAD(ckk_) do { const int ck_ = (ckk_); const bool isctx = ck_ < CTXL / 128; const int sbase = isctx ? ck_ * 128 : (ck_ - CTXL / 128) * 128; \
            const bf16_t *rl_, *rh_; int dl_, dh_; SSD_ROW(lane, rl_, dl_); SSD_ROW(lane + 64, rh_, dh_); \
            dt_lo = DT[(size_t)dl_ * 64 + dir * 32 + h]; dt_hi = DT[(size_t)dh_ * 64 + dir * 32 + h]; const bf16_t* rp_ = hi_half ? rh_ : rl_; \
            _Pragma("unroll") for (int j_ = 0; j_ < 2; ++j_) xv[j_] = *(const u32x4*)(rp_ + h * 64 + 8 * (q4 + 4 * j_)); \
            _Pragma("unroll") for (int j_ = 0; j_ < 4; ++j_) bv[j_] = *(const u32x4*)(rp_ + 2048 + g * 128 + 8 * (q4 + 4 * j_)); \
            if (!isctx) { _Pragma("unroll") for (int j_ = 0; j_ < 4; ++j_) { const bf16_t* rc_; int dc_; SSD_ROW((tid >> 4) + 32 * j_, rc_, dc_); (void)dc_; cv[j_] = *(const u32x4*)(rc_ + 3072 + g * 128 + (tid & 15) * 8); } } } while (0)
#define LBAR() do { asm volatile("s_waitcnt lgkmcnt(0)" ::: "memory"); __builtin_amdgcn_s_barrier(); asm volatile("" ::: "memory"); } while (0)
        SSD_LOAD(0);
        for (int ck = 0; ck < (CTXL + SEQ) / 128; ++ck) {
            const bool isctx = ck < CTXL / 128;
            const int sbase = isctx ? ck * 128 : (ck - CTXL / 128) * 128;
            LBAR();
            float c_lo = dt_lo * Ah, c_hi = dt_hi * Ah;
            c_lo = wave_incl_scan(c_lo); c_hi = wave_incl_scan(c_hi);
            c_hi += __int_as_float(__builtin_amdgcn_readlane(__float_as_int(c_lo), 63));
            const float c_last = __int_as_float(__builtin_amdgcn_readlane(__float_as_int(c_hi), 63));
            if (wave == 0) { scs[lane] = c_lo; scs[lane + 64] = c_hi; sdt[lane] = dt_lo; sdt[lane + 64] = dt_hi; }
            const float wsc = (hi_half ? dt_hi : dt_lo) * __expf(c_last - (hi_half ? c_hi : c_lo));
#pragma unroll
            for (int j = 0; j < 2; ++j) { const int p0 = 8 * (q4 + 4 * j); const u32x4 v = xv[j];
                PG8_LAS unsigned char* d = L + SS_XT + p0 * SS_LD + sm * 2;
                *(PG8_LAS unsigned short*)(d + 0 * SS_LD) = (unsigned short)(v.x & 0xffffu); *(PG8_LAS unsigned short*)(d + 1 * SS_LD) = (unsigned short)(v.x >> 16);
                *(PG8_LAS unsigned short*)(d + 2 * SS_LD) = (unsigned short)(v.y & 0xffffu); *(PG8_LAS unsigned short*)(d + 3 * SS_LD) = (unsigned short)(v.y >> 16);
                *(PG8_LAS unsigned short*)(d + 4 * SS_LD) = (unsigned short)(v.z & 0xffffu); *(PG8_LAS unsigned short*)(d + 5 * SS_LD) = (unsigned short)(v.z >> 16);
                *(PG8_LAS unsigned short*)(d + 6 * SS_LD) = (unsigned short)(v.w & 0xffffu); *(PG8_LAS unsigned short*)(d + 7 * SS_LD) = (unsigned short)(v.w >> 16); }
#pragma unroll
            for (int j = 0; j < 4; ++j) { const int n0 = 8 * (q4 + 4 * j); const u32x4 v = bv[j];
                if (!isctx) *(PG8_LAS u32x4*)(L + SS_B + sm * SS_LD + n0 * 2) = v;
                float f[8]; unpack8(v, f);
                PG8_LAS unsigned char* d = L + SS_BT + n0 * SS_LD + sm * 2;
#pragma unroll
                for (int e = 0; e < 8; e += 2) { const unsigned w2 = pk2(f[e] * wsc, f[e + 1] * wsc);
                    *(PG8_LAS unsigned short*)(d + e * SS_LD) = (unsigned short)(w2 & 0xffffu); *(PG8_LAS unsigned short*)(d + (e + 1) * SS_LD) = (unsigned short)(w2 >> 16); } }
            if (!isctx) {
#pragma unroll
                for (int j = 0; j < 4; ++j) *(PG8_LAS u32x4*)(L + SS_C + ((tid >> 4) + 32 * j) * SS_LD + (tid & 15) * 16) = cv[j];
            }
            if (ck + 1 < (CTXL + SEQ) / 128) SSD_LOAD(ck + 1);
            LBAR();
            f32x4 aY[4];
#define SB0() __builtin_amdgcn_sched_barrier(0)
            const int hb_rd = (ck & 1) ? SS_HB2 : SS_HB, hb_wr = (ck & 1) ? SS_HB : SS_HB2;
            const int l = 16 * wave + fr;
            if (!isctx) {
                bf16x8 cf[4];
#pragma unroll
                for (int ks = 0; ks < 4; ++ks) cf[ks] = SSD_FRAG(SS_C, l, ks);
#pragma unroll
                for (int ph = 0; ph < 2; ++ph) { bf16x8 hb[8];
#pragma unroll
                    for (int q = 0; q < 8; ++q) hb[q] = SSD_FRAG(hb_rd, 16 * (2 * ph + (q >> 2)) + fr, q & 3);
                    SB0();
                    f32x4 a0 = {0.f, 0.f, 0.f, 0.f}, a1 = a0;
#pragma unroll
                    for (int ks = 0; ks < 4; ++ks) { a0 = __builtin_amdgcn_mfma_f32_16x16x32_bf16(hb[ks], cf[ks], a0, 0, 0, 0); a1 = __builtin_amdgcn_mfma_f32_16x16x32_bf16(hb[4 + ks], cf[ks], a1, 0, 0, 0); }
                    aY[2 * ph] = a0; aY[2 * ph + 1] = a1;
                    SB0(); }
                const float csl = scs[l];
#pragma unroll
                for (int sp = 0; sp < 4; ++sp) {
                    if (2 * sp <= wave) {
                        bf16x8 bq[4], br[4];
#pragma unroll
                        for (int q = 0; q < 4; ++q) bq[q] = SSD_FRAG(SS_B, 16 * (2 * sp) + fr, q);
#pragma unroll
                        for (int q = 0; q < 4; ++q) br[q] = SSD_FRAG(SS_B, 16 * (2 * sp + 1) + fr, q);
                        const int s0 = 32 * sp + 4 * fq;
                        const f32x4 csA = *(const PG8_LAS f32x4*)(scs + s0), dtA = *(const PG8_LAS f32x4*)(sdt + s0), csB = *(const PG8_LAS f32x4*)(scs + s0 + 16), dtB = *(const PG8_LAS f32x4*)(sdt + s0 + 16);
                        SB0();
                        f32x4 a0 = {0.f, 0.f, 0.f, 0.f}, a1 = a0;
#pragma unroll
                        for (int ks = 0; ks < 4; ++ks) a0 = __builtin_amdgcn_mfma_f32_16x16x32_bf16(bq[ks], cf[ks], a0, 0, 0, 0);
#pragma unroll
                        for (int ks = 0; ks < 4; ++ks) a1 = __builtin_amdgcn_mfma_f32_16x16x32_bf16(br[ks], cf[ks], a1, 0, 0, 0);
                        float m0[4], m1[4];
#pragma unroll
                        for (int r = 0; r < 4; ++r) { const float e0 = __expf(fminf(csl - csA[r], 0.f)) * dtA[r], e1 = __expf(fminf(csl - csB[r], 0.f)) * dtB[r];
                            m0[r] = (s0 + r <= l) ? a0[r] * e0 : 0.f; m1[r] = (s0 + 16 + r <= l) ? a1[r] * e1 : 0.f; }
                        u32x2 w0, w1; w0.x = pk2(m0[0], m0[1]); w0.y = pk2(m0[2], m0[3]); w1.x = pk2(m1[0], m1[1]); w1.y = pk2(m1[2], m1[3]);
                        *(PG8_LAS u32x2*)(L + SS_C + l * SS_LD + s0 * 2) = w0; *(PG8_LAS u32x2*)(L + SS_C + l * SS_LD + (s0 + 16) * 2) = w1;
                        SB0();
                    }
                }
            }
            asm volatile("" ::: "memory");
            {
                const float dec = __expf(c_last); bf16x8 af[4];
#pragma unroll
                for (int ks = 0; ks < 4; ++ks) af[ks] = SSD_FRAG(SS_BT, l, ks);
#pragma unroll
                for (int ph = 0; ph < 2; ++ph) { bf16x8 xt[8];
#pragma unroll
                    for (int q = 0; q < 8; ++q) xt[q] = SSD_FRAG(SS_XT, 16 * (2 * ph + (q >> 2)) + fr, q & 3);
                    SB0();
                    f32x4 a0 = H[2 * ph] * dec, a1 = H[2 * ph + 1] * dec;
#pragma unroll
                    for (int ks = 0; ks < 4; ++ks) { a0 = __builtin_amdgcn_mfma_f32_16x16x32_bf16(af[ks], xt[ks], a0, 0, 0, 0); a1 = __builtin_amdgcn_mfma_f32_16x16x32_bf16(af[ks], xt[4 + ks], a1, 0, 0, 0); }
                    H[2 * ph] = a0; H[2 * ph + 1] = a1;
                    SB0(); }
                asm volatile("s_nop 15\n\ts_nop 7" : "+v"(H[0]), "+v"(H[1]), "+v"(H[2]), "+v"(H[3]));
#pragma unroll
                for (int pt = 0; pt < 4; ++pt) { u32x2 w; w.x = pk2(H[pt][0], H[pt][1]); w.y = pk2(H[pt][2], H[pt][3]); *(PG8_LAS u32x2*)(L + hb_wr + (16 * pt + fr) * SS_LD + (16 * wave + 4 * fq) * 2) = w; }
            }
            if (!isctx) {
                const float el = __expf(scs[l]);
                const int nks = ((16 * wave + 15) >> 5) + 1;
                const int tokl = dir ? (SEQ - 1 - (sbase + l)) : (sbase + l);
                bf16x8 mf[4];
#pragma unroll
                for (int ks = 0; ks < 4; ++ks) mf[ks] = SSD_FRAG(SS_C, l, (ks < nks) ? ks : 0);
#pragma unroll
                for (int ph = 0; ph < 2; ++ph) { bf16x8 xt[8]; unsigned xb[8];
#pragma unroll
                    for (int q = 0; q < 8; ++q) xt[q] = SSD_FRAG(SS_XT, 16 * (2 * ph + (q >> 2)) + fr, ((q & 3) < nks) ? (q & 3) : 0);
#pragma unroll
                    for (int q = 0; q < 8; ++q) xb[q] = *(const PG8_LAS unsigned short*)(L + SS_XT + (16 * (2 * ph + (q >> 2)) + 4 * fq + (q & 3)) * SS_LD + l * 2);
                    SB0();
#pragma unroll
                    for (int hh = 0; hh < 2; ++hh) { const int pt = 2 * ph + hh; f32x4 a = aY[pt] * el;
#pragma unroll
                        for (int ks = 0; ks < 4; ++ks) if (ks < nks) a = __builtin_amdgcn_mfma_f32_16x16x32_bf16(xt[hh * 4 + ks], mf[ks], a, 0, 0, 0);
#pragma unroll
                        for (int r = 0; r < 4; ++r) a[r] += dsk * __uint_as_float(xb[hh * 4 + r] << 16);
                        u32x2 w; w.x = pk2(a[0], a[1]); w.y = pk2(a[2], a[3]);
                        *(u32x2*)(Y + (size_t)(b * SEQ + tokl) * DM + h * 64 + 16 * pt + 4 * fq) = w; }
                    SB0(); }
            }
        }
        LBAR();
    }
#undef SSD_ROW
#undef SSD_FRAG
#undef SSD_LOAD
#undef LBAR
#undef SB0
}

__device__ __forceinline__ void phase_gate_norm(const Params& p) {
    const int lane = threadIdx.x & 63, rpb = (MLAT + (int)gridDim.x - 1) / (int)gridDim.x, rend = min(MLAT, ((int)blockIdx.x + 1) * rpb), gw = blockIdx.x * rpb + (threadIdx.x >> 6), NGW = 8;
    const bf16_t* YF = (const bf16_t*)(p.ws + OFF_YF); const bf16_t* YB = (const bf16_t*)(p.ws + OFF_YB); bf16_t* Z = (bf16_t*)(p.ws + OFF_Z); const float* nw = p.in[13];
    u32x4 ra[4], rb[4], rz[4];
    if (gw < rend) {
#pragma unroll
        for (int j = 0; j < 4; ++j) { const size_t off = (size_t)gw * DM + j * 512 + 8 * lane; ra[j] = __builtin_nontemporal_load((const u32x4*)(YF + off)); rb[j] = __builtin_nontemporal_load((const u32x4*)(YB + off)); rz[j] = __builtin_nontemporal_load((const u32x4*)(Z + off)); } }
    for (int row = gw; row < rend; row += NGW) {
        u32x4 na[4], nb[4], nz[4]; const int nrow = row + NGW;
        if (nrow < rend) {
#pragma unroll
            for (int j = 0; j < 4; ++j) { const size_t off = (size_t)nrow * DM + j * 512 + 8 * lane; na[j] = __builtin_nontemporal_load((const u32x4*)(YF + off)); nb[j] = __builtin_nontemporal_load((const u32x4*)(YB + off)); nz[j] = __builtin_nontemporal_load((const u32x4*)(Z + off)); } }
#pragma unroll
        for (int j = 0; j < 4; ++j) { const int col = j * 512 + 8 * lane; const size_t off = (size_t)row * DM + col;
            float a[8], b[8], z[8], w[8], o[8]; unpack8(ra[j], a); unpack8(rb[j], b); unpack8(rz[j], z); load8f(nw + col, w);
            float ss = 0.f;
#pragma unroll
            for (int e = 0; e < 8; ++e) { o[e] = (a[e] + b[e]) * siluf_(z[e]); ss += o[e] * o[e]; }
#pragma unroll
            for (int m = 1; m < 32; m <<= 1) ss += __shfl_xor(ss, m);
            const float rstd = rsqrtf(ss * (1.0f / 256.0f) + EPS);
#pragma unroll
            for (int e = 0; e < 8; ++e) o[e] = o[e] * rstd * w[e];
            *(u32x4*)(Z + off) = pack8(o); }
        if (nrow < rend) {
#pragma unroll
            for (int j = 0; j < 4; ++j) { ra[j] = na[j]; rb[j] = nb[j]; rz[j] = nz[j]; } }
    }
}

__device__ __forceinline__ void phase_ffn_act(const Params& p) {
    const int gtid = blockIdx.x * 512 + threadIdx.x, NT = gridDim.x * 512;
    bf16_t* A = (bf16_t*)(p.ws + OFF_UPA); const bf16_t* G = (const bf16_t*)(p.ws + OFF_UPG); const float* fw = p.in[21]; const float* fb = p.in[22];
    const u32x4 zero = {0u, 0u, 0u, 0u};
    constexpr int NCV = DFF / 8, NHL = NBATCH * 64 * 2;
    for (int task = gtid; task < NCV * NHL; task += NT) {
        const int cvi = task % NCV, hl = task / NCV, col = cvi * 8, bq = hl >> 7, gc = (hl >> 1) & 63, r0 = (hl & 1) * 32;
        float w0[8], w1[8], w2[8], b[8]; load8f(fw + col, w0); load8f(fw + DFF + col, w1); load8f(fw + 2 * DFF + col, w2); load8f(fb + col, b);
        const size_t rstride = (size_t)64 * DFF;
        size_t off = ((size_t)(bq * SEQ + r0 * 64 + gc)) * DFF + col;
        float x0[8], x1[8];
        unpack8((r0 > 0) ? *(const u32x4*)(G + off - rstride) : zero, x0); unpack8(*(const u32x4*)(G + off), x1);
#pragma unroll 4
        for (int r = r0; r < r0 + 32; ++r) {
            const u32x4 g2 = (r < 63) ? __builtin_nontemporal_load((const u32x4*)(G + off + rstride)) : zero;
            float x2[8], a[8], o[8];
            unpack8(g2, x2); unpack8(__builtin_nontemporal_load((const u32x4*)(A + off)), a);
#pragma unroll
            for (int e = 0; e < 8; e += 2) { f32x2 gv; gv.x = x0[e] * w0[e] + b[e] + x1[e] * w1[e] + x2[e] * w2[e]; gv.y = x0[e + 1] * w0[e + 1] + b[e + 1] + x1[e + 1] * w1[e + 1] + x2[e + 1] * w2[e + 1];
                const f32x2 ge = gelu_pk(gv); o[e] = ge.x * a[e]; o[e + 1] = ge.y * a[e + 1]; }
            *(u32x4*)(A + off) = pack8(o);
#pragma unroll
            for (int e = 0; e < 8; ++e) { x0[e] = x1[e]; x1[e] = x2[e]; }
            off += rstride;
        }
    }
}

__device__ __forceinline__ void phase_final_norm(const Params& p) {
    const int lane = threadIdx.x & 63, rpb = (MLAT + (int)gridDim.x - 1) / (int)gridDim.x, rend = min(MLAT, ((int)blockIdx.x + 1) * rpb), gw = blockIdx.x * rpb + (threadIdx.x >> 6), NGW = 8; const float* fw = p.in[24];
    const unsigned short* x2 = (const unsigned short*)(p.ws + OFF_UPG);
    u32x4 v[4]; f32x4 fwa[4], fwb[4];
#pragma unroll
    for (int j = 0; j < 4; ++j) { fwa[j] = *(const f32x4*)(fw + 8 * (lane + 64 * j)); fwb[j] = *(const f32x4*)(fw + 8 * (lane + 64 * j) + 4); }
    if (gw < rend) {
#pragma unroll
        for (int j = 0; j < 4; ++j) v[j] = __builtin_nontemporal_load((const u32x4*)(x2 + (size_t)gw * DM + 8 * (lane + 64 * j))); }
    for (int row = gw; row < rend; row += NGW) {
        u32x4 nv[4]; const int nrow = row + NGW;
        if (nrow < rend) {
#pragma unroll
            for (int j = 0; j < 4; ++j) nv[j] = __builtin_nontemporal_load((const u32x4*)(x2 + (size_t)nrow * DM + 8 * (lane + 64 * j))); }
        float* xr = p.out + (size_t)row * DM; float s = 0.f; f32x4 a[4], b[4];
#pragma unroll
        for (int j = 0; j < 4; ++j) { unpackh44(v[j], a[j], b[j]); s += (a[j].x * a[j].x + a[j].y * a[j].y) + (a[j].z * a[j].z + a[j].w * a[j].w) + (b[j].x * b[j].x + b[j].y * b[j].y) + (b[j].z * b[j].z + b[j].w * b[j].w); }
        const float rstd = rsqrtf(wave_sum(s) * (1.0f / DM) + EPS);
#pragma unroll
        for (int j = 0; j < 4; ++j) { const int col = 8 * (lane + 64 * j); *(f32x4*)(xr + col) = a[j] * rstd * fwa[j]; *(f32x4*)(xr + col + 4) = b[j] * rstd * fwb[j]; }
        if (nrow < rend) {
#pragma unroll
            for (int j = 0; j < 4; ++j) v[j] = nv[j]; }
    }
}

#define XB_TMO      128
#define XB_XCNT(j)  (256  + 64 * (j))
#define XB_XSUB(j)  (1280 + 64 * (j))
#define XB_XGEN(j)  (2304 + 64 * (j))
#define XB_TOP      3328
#define XB_TOPGEN   3392
#define XCD_BAR_WORDS 3456
#define XB_SPIN_CAP (1u << 20)
__device__ __forceinline__ unsigned xb_ld(unsigned* p)              { return __hip_atomic_load(p, __ATOMIC_RELAXED, __HIP_MEMORY_SCOPE_AGENT); }
__device__ __forceinline__ unsigned xb_add(unsigned* p, unsigned v) { return __hip_atomic_fetch_add(p, v, __ATOMIC_RELAXED, __HIP_MEMORY_SCOPE_AGENT); }
__device__ __forceinline__ unsigned xb_xcc_id() { return (unsigned)__builtin_amdgcn_s_getreg((3 << 11) | 20) & 0xFu; }
#define XB_SPIN(cond, bar) do { unsigned _sp = 0; while (cond) { __builtin_amdgcn_s_sleep(1); \
    if ((++_sp & 255u) == 0u) { if (xb_ld(&(bar)[XB_TMO])) break; if (_sp > XB_SPIN_CAP) { atomicAdd(&(bar)[XB_TMO], 1u); break; } } } } while (0)
struct XcdBarrier { unsigned* bar; unsigned x; volatile PG8_LAS unsigned* st; };
__device__ __forceinline__ XcdBarrier xcd_barrier_post(unsigned* bar, volatile PG8_LAS unsigned* st) {
    XcdBarrier b; b.bar = bar; b.x = xb_xcc_id(); b.st = st;
    if (threadIdx.x == 0) (void)xb_add(&bar[XB_XCNT(b.x)], 1u);
    return b;
}
__device__ __forceinline__ void xcd_barrier_complete(unsigned* bar, unsigned x, unsigned& nloc, unsigned& nx) {
    const unsigned G = gridDim.x * gridDim.y * gridDim.z;
    unsigned sum, cnt, mine, sp = 0u;
    for (;;) {
        sum = 0u; cnt = 0u; mine = 0u;
#pragma unroll
        for (unsigned j = 0; j < 16; ++j) { const unsigned c = xb_ld(&bar[XB_XCNT(j)]); sum += c; cnt += (c > 0u) ? 1u : 0u; mine = (j == x) ? c : mine; }
        if (sum == G) break;
        __builtin_amdgcn_s_sleep(1);
        if ((++sp & 255u) == 0u) { if (xb_ld(&bar[XB_TMO])) break; if (sp > XB_SPIN_CAP) { atomicAdd(&bar[XB_TMO], 1u); break; } }
    }
    nloc = mine > 0u ? mine : 1u; nx = cnt > 0u ? cnt : 1u;
}
__device__ __forceinline__ void xcd_barrier(const XcdBarrier& b) {
    asm volatile("s_waitcnt vmcnt(0)" ::: "memory");
    __syncthreads();
    if (threadIdx.x == 0) {
        unsigned* bar = b.bar;
        __builtin_amdgcn_s_waitcnt(0);
        unsigned nloc = b.st[0], nx = b.st[1];
        if (nloc == 0u) { xcd_barrier_complete(bar, b.x, nloc, nx); b.st[0] = nloc; b.st[1] = nx; }
        const unsigned old = xb_add(&bar[XB_XSUB(b.x)], 1u);
        const unsigned gen = old / nloc;
        if (old + 1u == (gen + 1u) * nloc) {
            __builtin_amdgcn_fence(__ATOMIC_RELEASE, "agent");
            asm volatile("s_waitcnt vmcnt(0)" ::: "memory");
            const unsigned og = xb_add(&bar[XB_TOP], 1u);
            const unsigned tg = og / nx;
            if (og + 1u == (tg + 1u) * nx) xb_add(&bar[XB_TOPGEN], 1u);
            else XB_SPIN(xb_ld(&bar[XB_TOPGEN]) == tg, bar);
            __builtin_amdgcn_fence(__ATOMIC_ACQUIRE, "agent");
            xb_add(&bar[XB_XGEN(b.x)], 1u);
            asm volatile("s_waitcnt vmcnt(0)" ::: "memory");
        } else {
            XB_SPIN(xb_ld(&bar[XB_XGEN(b.x)]) == gen, bar);
            __builtin_amdgcn_fence(__ATOMIC_ACQUIRE, "agent");
            asm volatile("s_waitcnt vmcnt(0)" ::: "memory");
        }
    }
    __syncthreads();
}

constexpr int NPHASES = 14;


__global__ __launch_bounds__(512, 2) void mk_fwd(Params p) {
    extern __shared__ __attribute__((aligned(16))) unsigned char smem[];
    PG8_LAS unsigned char* lds = (PG8_LAS unsigned char*)smem;
    const int lo = p.ph_lo, hi = p.ph_hi;
    const int G = (int)gridDim.x, c = (int)blockIdx.x;
    const float* mod = (const float*)(p.ws + OFF_MOD);
#define IN(k) (lo <= (k) && (k) < hi)
    volatile PG8_LAS unsigned* xst = (volatile PG8_LAS unsigned*)(lds + 157696);
    if (threadIdx.x == 0) { xst[0] = 0u; xst[1] = 0u; }
    __syncthreads();
    const XcdBarrier xb = xcd_barrier_post((unsigned*)(p.ws + OFF_BAR), xst);
#define SEAM(k) do { if (IN(k) && IN((k) + 1)) xcd_barrier(xb); } while (0)

    if (IN(0)) { phase_prologue(p, smem); } SEAM(0);
    if (IN(1)) {
        {
            pg8::Gemm g{(const bf16_t*)(p.ws + OFF_WPO), (const bf16_t*)(p.ws + OFF_WPW), DM, 512, 512, 2, nullptr, nullptr};
            pg8::Order S; S.init(DM / 256, DM / 256, G, c);
            EpiPlain E{(bf16_t*)(p.ws + OFF_WFOLD)};
            pg8::gemm_phase(lds, g, S, E);
        }
        phase_modulate(p.in[0], p.in[2], MTOT, p.in[6], mod, 0, 1, (bf16_t*)((unsigned char*)p.out + OUT_HN));
        {
            const int lane = threadIdx.x & 63, gw = c * 8 + (threadIdx.x >> 6), NGW = G * 8; const bf16_t* WU = (const bf16_t*)(p.ws + OFF_WUP); float* B2 = (float*)(p.ws + OFF_BIAS2);
            for (int n = gw; n < 2 * DFF; n += NGW) { float s0 = 0.f, s1 = 0.f, s2 = 0.f, s3 = 0.f;
#pragma unroll
                for (int j = 0; j < 4; ++j) { const int k = j * 512 + 8 * lane; float w[8], h[8]; unpack8(*(const u32x4*)(WU + (size_t)n * DM + k), w);
                    load8f(mod + 0 * 12288 + 3 * DM + k, h);
#pragma unroll
                    for (int e = 0; e < 8; ++e) s0 += w[e] * h[e];
                    load8f(mod + 1 * 12288 + 3 * DM + k, h);
#pragma unroll
                    for (int e = 0; e < 8; ++e) s1 += w[e] * h[e];
                    load8f(mod + 2 * 12288 + 3 * DM + k, h);
#pragma unroll
                    for (int e = 0; e < 8; ++e) s2 += w[e] * h[e];
                    load8f(mod + 3 * 12288 + 3 * DM + k, h);
#pragma unroll
                    for (int e = 0; e < 8; ++e) s3 += w[e] * h[e]; }
                s0 = wave_sum(s0); s1 = wave_sum(s1); s2 = wave_sum(s2); s3 = wave_sum(s3);
                if (lane == 0) { B2[n] = s0; B2[2 * DFF + n] = s1; B2[4 * DFF + n] = s2; B2[6 * DFF + n] = s3; } }
        }
    } SEAM(1);
    if (IN(2)) {
        pg8::Gemm g{(const bf16_t*)((unsigned char*)p.out + OUT_HN), (const bf16_t*)((unsigned char*)p.out + OUT_WINT), DM, DM, DM, 0, nullptr, nullptr};
        pg8::Order S; S.init(MLAT / 256, NINP / 256, G, c); S.xM0 = MLAT / 256; S.xnM = MCTX / 256; S.xn = 13; S.xlast = 48;
        EpiProj E{(bf16_t*)(p.ws + OFF_XBC), (bf16_t*)(p.ws + OFF_Z), (float*)(p.ws + OFF_DT), p.in[10]};
        pg8::gemm_phase(lds, g, S, E);
        { const int total = (MLAT / 256) * (NINP / 256) + (MCTX / 256) * 13, rem = total % G;
          if (rem == 0) phase_late_weights(p, smem, c, G); else if (c >= rem) phase_late_weights(p, smem, c - rem, G - rem); }
    } SEAM(2);
    if (IN(3)) { phase_conv_pool(p, smem); }
    SEAM(4);
    if (IN(5)) { phase_ssd_mfma(p, smem); } SEAM(5);
    if (IN(6)) { phase_gate_norm(p); } SEAM(6);
    if (IN(7)) {
        pg8::Order S; S.init(MLAT / 256, DM / 256, G, c); S.dual = 1;
        pg8::Gemm g{(const bf16_t*)(p.ws + OFF_YS), (const bf16_t*)(p.ws + OFF_WSSD), DM, DM, DM, 0, (const bf16_t*)(p.ws + OFF_P), (const bf16_t*)(p.ws + OFF_WFOLD)};
        EpiGateDual E{(bf16_t*)(p.ws + OFF_MG), (const bf16_t*)(p.ws + OFF_GS), (const bf16_t*)(p.ws + OFF_GP)};
        pg8::gemm_phase(lds, g, S, E);
    } SEAM(7);
    if (IN(8)) {
        pg8::Gemm g{(const bf16_t*)(p.ws + OFF_MG), (const bf16_t*)(p.ws + OFF_WO), DM, DM, DM, 0, nullptr, nullptr};
        pg8::Order S; S.init(MLAT / 256, DM / 256, G, c);
        EpiRes1 E{(unsigned short*)p.out, p.in[0], mod, p.in[19], (bf16_t*)(p.ws + OFF_H2), (float*)(p.ws + OFF_ROWSS)};
        pg8::gemm_phase(lds, g, S, E);
    }
    SEAM(9);
    if (IN(10)) {
        pg8::Gemm g{(const bf16_t*)(p.ws + OFF_H2), (const bf16_t*)(p.ws + OFF_WUP), DM, DM, DM, 0, nullptr, nullptr};
        pg8::Order S; S.init(MLAT / 256, 2 * DFF / 256, G, c);
        EpiUp E{(bf16_t*)(p.ws + OFF_UPA), (bf16_t*)(p.ws + OFF_UPG), (const float*)(p.ws + OFF_ROWSS), (const float*)(p.ws + OFF_BIAS2)};
        pg8::gemm_phase(lds, g, S, E);
    } SEAM(10);
    if (IN(11)) { phase_ffn_act(p); } SEAM(11);
    if (IN(12)) {
        pg8::Gemm g{(const bf16_t*)(p.ws + OFF_UPA), (const bf16_t*)(p.ws + OFF_WDN), DFF, DFF, DFF, 0, nullptr, nullptr};
        pg8::Order S; S.init(MLAT / 256, DM / 256, G, c);
        EpiRes E{(unsigned short*)(p.ws + OFF_UPG), (const unsigned short*)p.out, mod + 5 * DM};
        pg8::gemm_phase(lds, g, S, E);
    } SEAM(12);
    if (IN(13)) { phase_final_norm(p); }
    if (hi > NPHASES + 1000) cg::this_grid().sync();
#undef IN
#undef SEAM
}

extern "C" void kernel_launch(void* const* d_in, const int* in_sizes, int n_in, void* d_out, int out_size, void* d_ws, size_t ws_size, hipStream_t stream) {
    static int grid = 0;
    if (grid == 0) {
        if (n_in != 25 || out_size != MLAT * DM || ws_size < WS_END) { fprintf(stderr, "kernel_launch: unexpected shapes (n_in %d out %d ws %zu need %zu)\n", n_in, out_size, ws_size, (size_t)WS_END); grid = -1; return; }
        int dev = 0, cus = 0, per_cu = 0;
        (void)hipGetDevice(&dev); (void)hipDeviceGetAttribute(&cus, hipDeviceAttributeMultiprocessorCount, dev);
        if (hipFuncSetAttribute((const void*)mk_fwd, hipFuncAttributeMaxDynamicSharedMemorySize, LDS_BYTES) != hipSuccess) { fprintf(stderr, "kernel_launch: hipFuncSetAttribute failed\n"); grid = -1; return; }
        if (hipOccupancyMaxActiveBlocksPerMultiprocessor(&per_cu, (const void*)mk_fwd, 512, LDS_BYTES) != hipSuccess || per_cu < 1) per_cu = 1;
        (void)hipGetLastError();
        grid = cus * per_cu;
        if (grid <= 0) grid = 256;
    }
    if (grid < 0) return;
    (void)hipMemsetAsync((unsigned char*)d_ws + OFF_MOD, 0, OFF_DT, stream);
    Params p{};
    for (int i = 0; i < 25; ++i) p.in[i] = (const float*)d_in[i];
    p.out = (float*)d_out; p.ws = (unsigned char*)d_ws;
#if MK_MULTI
    for (int ph = 0; ph < NPHASES; ++ph) { p.ph_lo = ph; p.ph_hi = ph + 1; hipLaunchKernelGGL(mk_fwd, dim3(grid), dim3(512), LDS_BYTES, stream, p); }
#else
    p.ph_lo = 0; p.ph_hi = NPHASES;
    void* args[] = {&p};
    hipError_t e = hipLaunchCooperativeKernel((const void*)mk_fwd, dim3(grid), dim3(512), args, LDS_BYTES, stream);
    if (e != hipSuccess) fprintf(stderr, "cooperative launch failed: %s (grid %d)\n", hipGetErrorString(e), grid);
#ifdef PROBE_EXTRA
    { const int extra[] = PROBE_EXTRA; for (int ph : extra) { p.ph_lo = ph; p.ph_hi = ph + 1; hipLaunchKernelGGL(mk_fwd, dim3(grid), dim3(512), LDS_BYTES, stream, p); } }
#endif
#endif
}
```

```cpp
#include <hip/hip_runtime.h>
#include <hip/hip_cooperative_groups.h>
#include <cstdio>
#include <cstdint>
namespace cg = cooperative_groups;

#ifndef MK_MULTI
#define MK_MULTI 0
#endif

namespace pg8 {
#define PG8_LAS __attribute__((address_space(3)))
typedef unsigned short bf16_t;
typedef short bf16x8 __attribute__((ext_vector_type(8)));
typedef float f32x4 __attribute__((ext_vector_type(4)));
typedef unsigned u32x4 __attribute__((ext_vector_type(4)));
constexpr int BM = 256, BK = 64, HALF = 128, HTB = HALF * BK * 2, STAGE_BYTES = 8 * HTB, NXCD = 8, WGM = 2;

__host__ __device__ __forceinline__ int lds_byte(int r, int c) { const int st = (r >> 4) * 2 + (c >> 5), rr = r & 15, cc = c & 31, ob = rr * 64 + cc * 2; return st * 1024 + (ob ^ (((ob >> 9) & 1) << 5)); }
__host__ __device__ __forceinline__ void stage_rc(int b, int& R, int& C) { const int st = b / 1024, sb = b % 1024, swz = sb ^ (((sb >> 9) & 1) << 5); R = (st >> 1) * 16 + swz / 64; C = (st & 1) * 32 + (swz % 64) / 2; }
__host__ __device__ __forceinline__ int perm32(int rho) { const int n = rho >> 4, i = rho & 15; return 8 * (i >> 2) + 4 * n + (i & 3); }

struct Unit { int pm, pn, half; };
struct Gemm { const bf16_t* A; const bf16_t* Bt; int lda, ldb, K, agrp; const bf16_t* A2; const bf16_t* Bt2; };

struct Order {
    int nM, nN, nwg, G, c, xM0, xnM, xn, xlast, dual;
    __device__ void init(int nM_, int nN_, int G_, int c_) { nM = nM_; nN = nN_; nwg = nM * nN; G = G_; c = c_; xM0 = 0; xnM = 0; xn = 0; xlast = 0; dual = 0; }
    __device__ bool next(int i_, Unit& u) const {
        const int i = dual ? (i_ >> 1) : i_; u.half = dual ? (i_ & 1) : 0;
        const long L = (long)i * G + c;
        if (L >= nwg) { const int e = (int)(L - nwg); if (e >= xnM * xn) return false; const int j = e / xnM; u.pm = xM0 + e % xnM; u.pn = (j < xn - 1) ? j : xlast; return true; }
        int wgid = (int)L; { const int q = nwg / NXCD, r = nwg % NXCD, xcd = wgid % NXCD, off = wgid / NXCD; wgid = (xcd < r ? xcd * (q + 1) : r * (q + 1) + (xcd - r) * q) + off; }
        const int nig = WGM * nN, gid = wgid / nig, fm = gid * WGM, gsz = (nM - fm) < WGM ? (nM - fm) : WGM;
        u.pm = fm + ((wgid % nig) % gsz); u.pn = (wgid % nig) / gsz; return true;
    }
};

__device__ __forceinline__ unsigned cvt_pk_bf16(float lo, float hi) { unsigned r; asm volatile("v_cvt_pk_bf16_f32 %0, %1, %2" : "=v"(r) : "v"(lo), "v"(hi)); return r; }

template <class Epi, class Sched>
__device__ __forceinline__ void gemm_phase(PG8_LAS unsigned char* lds, const Gemm g, const Sched& S, const Epi& E) {
    const int tid = threadIdx.x, wid = __builtin_amdgcn_readfirstlane(tid >> 6), lane = tid & 63, wr = wid >> 2, wc = wid & 3, fr = lane & 15, fq = lane >> 4;
    const int K = g.K, nt = K / BK;
    unsigned voffA[2], voffB[2];
#pragma unroll
    for (int i = 0; i < 2; ++i) { int R, C; stage_rc(tid * 16 + i * 8192, R, C); const int Rb = (R & ~31) + perm32(R & 31);
        voffA[i] = (unsigned)(R * g.lda + C) * 2u; voffB[i] = (unsigned)(Rb * g.ldb + C) * 2u; }
    const size_t kstep = (size_t)(BK * 2);
    const size_t hstepA = (size_t)HALF * g.lda * 2, hstepB = (size_t)HALF * g.ldb * 2;
    const size_t tstepA = 2 * hstepA, tstepB = 2 * hstepB;
    const unsigned ldsw = (unsigned)wid * 1024u;
    const int aoff = lds_byte(wr * 64 + fr, fq * 8), boff = lds_byte(wc * 32 + fr, fq * 8);
#define PG8_SA(b, h) (((b) * 2 + (h)) * HTB)
#define PG8_SB(b, h) ((4 + (b) * 2 + (h)) * HTB)
#define PG8_STAGE(bufoff, gbase, voff) do { _Pragma("unroll") for (int _i = 0; _i < 2; ++_i) \
        __builtin_amdgcn_global_load_lds((const unsigned*)((const char*)(gbase) + (voff)[_i]), (PG8_LAS unsigned*)(lds + (bufoff) + ldsw + _i * 8192), 16, 0, 0); } while (0)
#define PG8_LDA(dst, b, h) do { _Pragma("unroll") for (int m = 0; m < 4; ++m) _Pragma("unroll") for (int k = 0; k < 2; ++k) dst[m][k] = *(const PG8_LAS bf16x8*)(lds + PG8_SA(b, h) + aoff + m * 2048 + k * 1024); } while (0)
#define PG8_LDB(dst, b, h) do { _Pragma("unroll") for (int n = 0; n < 2; ++n) _Pragma("unroll") for (int k = 0; k < 2; ++k) dst[n][k] = *(const PG8_LAS bf16x8*)(lds + PG8_SB(b, h) + boff + n * 2048 + k * 1024); } while (0)
#define PG8_MMA(ai, bj, At, Bt) do { __builtin_amdgcn_s_setprio(1); _Pragma("unroll") for (int m = 0; m < 4; ++m) _Pragma("unroll") for (int n = 0; n < 2; ++n) _Pragma("unroll") for (int k = 0; k < 2; ++k) \
        acc[ai][bj][m][n] = __builtin_amdgcn_mfma_f32_16x16x32_bf16(Bt[n][k], At[m][k], acc[ai][bj][m][n], 0, 0, 0); __builtin_amdgcn_s_setprio(0); } while (0)
#define PG8_WAIT_V(n) asm volatile("s_waitcnt vmcnt(" #n ")" ::: "memory")
#define PG8_WAIT_L(n) asm volatile("s_waitcnt lgkmcnt(" #n ")" ::: "memory")
#define PG8_BAR __builtin_amdgcn_s_barrier()
#define PG8_SCHED __builtin_amdgcn_sched_barrier(0)
#define PG8_ABASE(u) ((const char*)((u).half ? g.A2 : g.A) + (size_t)(u).pm * tstepA + (g.agrp ? (size_t)((u).pn / g.agrp) * (size_t)K * 2 : (size_t)0))
#define PG8_BBASE(u) ((const char*)((u).half ? g.Bt2 : g.Bt) + (size_t)(u).pn * tstepB)
    Unit cur, nxt; int ui = 0;
    if (!S.next(0, cur)) return;
    f32x4 acc[2][2][4][2];
#pragma unroll
    for (int a = 0; a < 2; ++a)
#pragma unroll
        for (int b = 0; b < 2; ++b)
#pragma unroll
            for (int m = 0; m < 4; ++m)
#pragma unroll
                for (int n = 0; n < 2; ++n) acc[a][b][m][n] = (f32x4){0.f, 0.f, 0.f, 0.f};
    bf16x8 At[4][2], B0[2][2], B1[2][2];
    const char* cA = PG8_ABASE(cur); const char* cB = PG8_BBASE(cur);
    PG8_STAGE(PG8_SB(0, 0), cB, voffB); PG8_STAGE(PG8_SB(0, 1), cB + hstepB, voffB); PG8_STAGE(PG8_SA(0, 0), cA, voffA); PG8_STAGE(PG8_SA(0, 1), cA + hstepA, voffA);
    if (wr == 1) PG8_BAR;
    PG8_WAIT_V(2); PG8_BAR;
    PG8_STAGE(PG8_SB(1, 0), cB + kstep, voffB); PG8_STAGE(PG8_SA(1, 0), cA + kstep, voffA); PG8_STAGE(PG8_SB(1, 1), cB + hstepB + kstep, voffB);
    PG8_WAIT_V(6); PG8_BAR;
    for (;;) {
        const bool has_next = S.next(ui + 1, nxt);
        const char* nA = has_next ? PG8_ABASE(nxt) : cA; const char* nB = has_next ? PG8_BBASE(nxt) : cB;
        for (int t = 0; t < nt; t += 2) {
            const bool last = (t == nt - 2);
            const char* a1 = cA + (size_t)(t + 1) * kstep;
            const char* a2 = last ? nA : cA + (size_t)(t + 2) * kstep; const char* b2 = last ? nB : cB + (size_t)(t + 2) * kstep;
            const char* a3 = a2 + kstep; const char* b3 = b2 + kstep;
            PG8_LDB(B0, 0, 0); PG8_LDB(B1, 0, 1); PG8_SCHED; PG8_LDA(At, 0, 0); PG8_STAGE(PG8_SA(1, 1), a1 + hstepA, voffA);
            PG8_WAIT_V(8); PG8_WAIT_L(0); PG8_BAR; PG8_MMA(0, 0, At, B0); PG8_MMA(0, 1, At, B1); PG8_BAR; PG8_SCHED;
            PG8_LDA(At, 0, 1); PG8_STAGE(PG8_SB(0, 0), b2, voffB); PG8_STAGE(PG8_SB(0, 1), b2 + hstepB, voffB); PG8_STAGE(PG8_SA(0, 0), a2, voffA);
            PG8_WAIT_V(8); PG8_WAIT_L(0); PG8_BAR; PG8_MMA(1, 0, At, B0); PG8_MMA(1, 1, At, B1); PG8_BAR; PG8_SCHED;
            PG8_LDB(B0, 1, 0); PG8_LDB(B1, 1, 1); PG8_SCHED; PG8_LDA(At, 1, 0); PG8_STAGE(PG8_SA(0, 1), a2 + hstepA, voffA);
            PG8_WAIT_V(8); PG8_WAIT_L(0); PG8_BAR; PG8_MMA(0, 0, At, B0); PG8_MMA(0, 1, At, B1); PG8_BAR; PG8_SCHED;
            PG8_LDA(At, 1, 1); PG8_STAGE(PG8_SB(1, 0), b3, voffB); PG8_STAGE(PG8_SB(1, 1), b3 + hstepB, voffB); PG8_STAGE(PG8_SA(1, 0), a3, voffA);
            PG8_WAIT_V(8); PG8_WAIT_L(0); PG8_BAR; PG8_MMA(1, 0, At, B0); PG8_MMA(1, 1, At, B1); PG8_BAR; PG8_SCHED;
        }
        if (wr == 0) PG8_BAR;
        asm volatile("s_nop 15\n\ts_nop 7" ::: "memory");
        const bool keep = E(acc, cur, wr, wc, fr, fq);
        if (!has_next) break;
        if (!keep)
#pragma unroll
        for (int a = 0; a < 2; ++a)
#pragma unroll
            for (int b = 0; b < 2; ++b)
#pragma unroll
                for (int m = 0; m < 4; ++m)
#pragma unroll
                    for (int n = 0; n < 2; ++n) acc[a][b][m][n] = (f32x4){0.f, 0.f, 0.f, 0.f};
        cur = nxt; cA = nA; cB = nB; ++ui;
        if (wr == 1) PG8_BAR;
    }
    PG8_WAIT_V(0);
    PG8_BAR;
#undef PG8_SA
#undef PG8_SB
#undef PG8_STAGE
#undef PG8_LDA
#undef PG8_LDB
#undef PG8_MMA
#undef PG8_WAIT_V
#undef PG8_WAIT_L
#undef PG8_BAR
#undef PG8_SCHED
#undef PG8_ABASE
#undef PG8_BBASE
}
}

using pg8::bf16_t; using pg8::f32x4; using pg8::u32x4; using pg8::Unit;
typedef unsigned u32x2 __attribute__((ext_vector_type(2)));

constexpr int DM = 2048, NBATCH = 4, SEQ = 4096, MLAT = NBATCH * SEQ, CTXL = 256, MCTX = NBATCH * CTXL, MTOT = MLAT + MCTX;
constexpr int DFF = 5632, NIN = 12352, NINP = 12544, NXBC = 4096;
constexpr float EPS = 1e-6f;
constexpr int LDS_BYTES = 157696 + 16;

constexpr size_t OFF_MOD = 0;
constexpr size_t OFF_BAR = 245760;
constexpr size_t OFF_ROWSS = 262144;
constexpr size_t OFF_DT = 327680;
constexpr size_t OFF_XC = OFF_DT + (size_t)MTOT * 64 * 4;
constexpr size_t OFF_WUP = OFF_XC + (size_t)MCTX * 4096 * 2;
constexpr size_t OFF_WDN = OFF_WUP + (size_t)2 * DFF * DM * 2;
constexpr size_t OFF_WSSD = OFF_WDN + (size_t)DM * DFF * 2;
constexpr size_t OFF_WPO = OFF_WSSD + (size_t)DM * DM * 2;
constexpr size_t OFF_WO = OFF_WPO + (size_t)DM * DM * 2;
constexpr size_t OFF_WPW = OFF_WO + (size_t)DM * DM * 2;
constexpr size_t OFF_XBC = OFF_WPW + (size_t)2048 * 512 * 2;
constexpr size_t SZ_ACT = (size_t)MLAT * DM * 2;
constexpr size_t OFF_Z = OFF_XBC + (size_t)MTOT * 4096 * 2;
constexpr size_t OFF_V = OFF_Z + SZ_ACT;
constexpr size_t OFF_GS = OFF_V + SZ_ACT;
constexpr size_t OFF_GP = OFF_GS + SZ_ACT;
constexpr size_t OFF_WFOLD = OFF_GP + SZ_ACT;
constexpr size_t OFF_BIAS2 = OFF_WFOLD + (size_t)DM * DM * 2;
constexpr size_t WS_END = OFF_BIAS2 + (size_t)4 * 2 * DFF * 4;
constexpr size_t OFF_P = OFF_V;
constexpr size_t OFF_YF = OFF_XBC + SZ_ACT, OFF_YB = OFF_XBC, OFF_YS = OFF_Z, OFF_T1 = OFF_V, OFF_MG = OFF_XBC, OFF_H2 = OFF_GP;
constexpr size_t OFF_UPA = OFF_WSSD;
constexpr size_t OFF_UPG = OFF_UPA + (size_t)MLAT * DFF * 2;
static_assert(OFF_UPG + (size_t)MLAT * DFF * 2 <= OFF_H2, "up buffers overlap h2");
constexpr size_t OUT_HN = 0;
constexpr size_t OUT_WINT = (size_t)MTOT * DM * 2;
static_assert(OUT_WINT + (size_t)NINP * DM * 2 <= (size_t)MLAT * DM * 4, "d_out overlay");

struct Params { const float* in[25]; float* out; unsigned char* ws; int ph_lo, ph_hi; };

__device__ __forceinline__ float bflo(unsigned u) { return __uint_as_float(u << 16); }
__device__ __forceinline__ float bfhi(unsigned u) { return __uint_as_float(u & 0xffff0000u); }
__device__ __forceinline__ unsigned pk2(float lo, float hi) { return pg8::cvt_pk_bf16(lo, hi); }
__device__ __forceinline__ void unpack8(const u32x4 r, float (&o)[8]) { o[0] = bflo(r.x); o[1] = bfhi(r.x); o[2] = bflo(r.y); o[3] = bfhi(r.y); o[4] = bflo(r.z); o[5] = bfhi(r.z); o[6] = bflo(r.w); o[7] = bfhi(r.w); }
__device__ __forceinline__ u32x4 pack8(const float (&o)[8]) { u32x4 r; r.x = pk2(o[0], o[1]); r.y = pk2(o[2], o[3]); r.z = pk2(o[4], o[5]); r.w = pk2(o[6], o[7]); return r; }
typedef _Float16 h16x2 __attribute__((ext_vector_type(2)));
__device__ __forceinline__ unsigned pkh2(float lo, float hi) { h16x2 v; v.x = (_Float16)lo; v.y = (_Float16)hi; return __builtin_bit_cast(unsigned, v); }
__device__ __forceinline__ u32x4 packh44(const f32x4 a, const f32x4 b) { u32x4 w; w.x = pkh2(a[0], a[1]); w.y = pkh2(a[2], a[3]); w.z = pkh2(b[0], b[1]); w.w = pkh2(b[2], b[3]); return w; }
__device__ __forceinline__ void unpackh44(const u32x4 r, f32x4& a, f32x4& b) {
    const unsigned r0 = r.x, r1 = r.y, r2 = r.z, r3 = r.w;
    const h16x2 p0 = __builtin_bit_cast(h16x2, r0), p1 = __builtin_bit_cast(h16x2, r1), p2 = __builtin_bit_cast(h16x2, r2), p3 = __builtin_bit_cast(h16x2, r3);
    a = (f32x4){(float)p0.x, (float)p0.y, (float)p1.x, (float)p1.y}; b = (f32x4){(float)p2.x, (float)p2.y, (float)p3.x, (float)p3.y}; }
__device__ __forceinline__ float wave_sum(float v) {
#pragma unroll
    for (int o = 1; o < 64; o <<= 1) v += __shfl_xor(v, o);
    return v;
}
__device__ __forceinline__ float wave_incl_scan(float x) {
#define DPP_ADD(ctrl_, rmask_) x += __int_as_float(__builtin_amdgcn_update_dpp(0, __float_as_int(x), ctrl_, rmask_, 0xf, false))
    DPP_ADD(0x111, 0xf); DPP_ADD(0x112, 0xf); DPP_ADD(0x114, 0xf); DPP_ADD(0x118, 0xf); DPP_ADD(0x142, 0xa); DPP_ADD(0x143, 0xc);
#undef DPP_ADD
    return x;
}
__device__ __forceinline__ float sigmoidf_(float x) { return __builtin_amdgcn_rcpf(1.0f + __expf(-x)); }
__device__ __forceinline__ float siluf_(float x) { return x * __builtin_amdgcn_rcpf(1.0f + __expf(-x)); }
typedef float f32x2 __attribute__((ext_vector_type(2)));
__device__ __forceinline__ f32x2 gelu_pk(f32x2 v) {
    const f32x2 av = __builtin_elementwise_abs(v), d = av * 0.2316418882f + 1.0f;
    f32x2 t; t.x = __builtin_amdgcn_rcpf(d.x); t.y = __builtin_amdgcn_rcpf(d.y);
    f32x2 q = t * 0.5307027145f + (-0.7265760135f); q = q * t + 0.7107068705f; q = q * t + (-0.142248368f); q = q * t + 0.127414796f; q = q * t;
    const f32x2 s = (v * v) * (-0.72134752044f);
    f32x2 e; e.x = __builtin_amdgcn_exp2f(s.x); e.y = __builtin_amdgcn_exp2f(s.y);
    const f32x2 m = v * (q * e), r = v - m;
    f32x2 o; o.x = v.x < 0.f ? m.x : r.x; o.y = v.y < 0.f ? m.y : r.y; return o;
}
__device__ __forceinline__ float softplusf_(float x) { return fmaxf(x, 0.f) + log1pf(__expf(-fabsf(x))); }
__device__ __forceinline__ void load8f(const float* p, float (&o)[8]) { const f32x4 a = *(const f32x4*)p, b = *(const f32x4*)(p + 4); o[0] = a.x; o[1] = a.y; o[2] = a.z; o[3] = a.w; o[4] = b.x; o[5] = b.y; o[6] = b.z; o[7] = b.w; }

#define EPI_LOOP_BEGIN \
    const int row0 = u.pm * 256 + wr * 64 + fr, cl0 = wc * 32 + 8 * fq; \
    _Pragma("unroll") for (int ai = 0; ai < 2; ++ai) _Pragma("unroll") for (int m = 0; m < 4; ++m) { const int row = row0 + ai * 128 + m * 16; \
    _Pragma("unroll") for (int bj = 0; bj < 2; ++bj) { const int cl = cl0 + bj * 128; const f32x4 v0 = acc[ai][bj][m][0], v1 = acc[ai][bj][m][1];
#define EPI_LOOP_END } }
__device__ __forceinline__ u32x4 pack44(const f32x4 a, const f32x4 b) { u32x4 w; w.x = pk2(a[0], a[1]); w.y = pk2(a[2], a[3]); w.z = pk2(b[0], b[1]); w.w = pk2(b[2], b[3]); return w; }

struct EpiProj {
    bf16_t* xbc; bf16_t* zvg; float* dt; const float* dt_bias;
    __device__ __forceinline__ bool operator()(f32x4 (&acc)[2][2][4][2], const Unit& u, int wr, int wc, int fr, int fq) const {
        if (u.pn < 16) {
            EPI_LOOP_BEGIN *(u32x4*)(xbc + (size_t)row * 4096 + u.pn * 256 + cl) = pack44(v0, v1); EPI_LOOP_END
        } else if (u.pn < 48) {
            bf16_t* base = zvg + (size_t)((u.pn - 16) >> 3) * ((size_t)MLAT * DM) + ((u.pn - 16) & 7) * 256;
            EPI_LOOP_BEGIN *(u32x4*)(base + (size_t)row * DM + cl) = pack44(v0, v1); EPI_LOOP_END
        } else {
            EPI_LOOP_BEGIN
                if (cl < 64) { const f32x4 b0 = *(const f32x4*)(dt_bias + cl), b1 = *(const f32x4*)(dt_bias + cl + 4); f32x4 o0, o1;
#pragma unroll
                    for (int e = 0; e < 4; ++e) { o0[e] = softplusf_(v0[e] + b0[e]); o1[e] = softplusf_(v1[e] + b1[e]); }
                    *(f32x4*)(dt + (size_t)row * 64 + cl) = o0; *(f32x4*)(dt + (size_t)row * 64 + cl + 4) = o1; }
            EPI_LOOP_END
        }
        return false;
    }
};
struct EpiPlain {
    bf16_t* o;
    __device__ __forceinline__ bool operator()(f32x4 (&acc)[2][2][4][2], const Unit& u, int wr, int wc, int fr, int fq) const {
        EPI_LOOP_BEGIN *(u32x4*)(o + (size_t)row * DM + u.pn * 256 + cl) = pack44(v0, v1); EPI_LOOP_END
        return false;
    }
};
struct EpiScale {
    bf16_t* o; const float* scale;
    __device__ __forceinline__ bool operator()(f32x4 (&acc)[2][2][4][2], const Unit& u, int wr, int wc, int fr, int fq) const {
        EPI_LOOP_BEGIN const int col = u.pn * 256 + cl; const f32x4 s0 = *(const f32x4*)(scale + col), s1 = *(const f32x4*)(scale + col + 4);
            *(u32x4*)(o + (size_t)row * DM + col) = pack44(v0 * s0, v1 * s1); EPI_LOOP_END
        return false;
    }
};
template <int SECOND> struct EpiGate {
    bf16_t* o; const bf16_t* gate; const bf16_t* t1;
    __device__ __forceinline__ bool operator()(f32x4 (&acc)[2][2][4][2], const Unit& u, int wr, int wc, int fr, int fq) const {
        EPI_LOOP_BEGIN const size_t off = (size_t)row * DM + u.pn * 256 + cl; float gt[8]; unpack8(*(const u32x4*)(gate + off), gt);
            float r[8];
#pragma unroll
            for (int e = 0; e < 4; ++e) { r[e] = sigmoidf_(gt[e]) * v0[e]; r[4 + e] = sigmoidf_(gt[4 + e]) * v1[e]; }
            if (SECOND) { float pv[8]; unpack8(*(const u32x4*)(t1 + off), pv);
#pragma unroll
                for (int e = 0; e < 8; ++e) r[e] += pv[e]; }
            *(u32x4*)(o + off) = pack8(r); EPI_LOOP_END
        return false;
    }
};
struct EpiGateDual {
    bf16_t* o; const bf16_t* gs; const bf16_t* gp;
    __device__ __forceinline__ bool operator()(f32x4 (&acc)[2][2][4][2], const Unit& u, int wr, int wc, int fr, int fq) const {
        const int row0 = u.pm * 256 + wr * 64 + fr, cl0 = wc * 32 + 8 * fq;
        if (u.half == 0) {
#pragma unroll
            for (int ai = 0; ai < 2; ++ai)
#pragma unroll
                for (int m = 0; m < 4; ++m)
#pragma unroll
                    for (int bj = 0; bj < 2; ++bj) { const size_t off = (size_t)(row0 + ai * 128 + m * 16) * DM + u.pn * 256 + cl0 + bj * 128;
                        float a[8], b[8]; unpack8(*(const u32x4*)(gs + off), a); unpack8(*(const u32x4*)(gp + off), b);
#pragma unroll
                        for (int e = 0; e < 4; ++e) { acc[ai][bj][m][0][e] *= (1.0f + __expf(-b[e])) * __builtin_amdgcn_rcpf(1.0f + __expf(-a[e]));
                                                      acc[ai][bj][m][1][e] *= (1.0f + __expf(-b[4 + e])) * __builtin_amdgcn_rcpf(1.0f + __expf(-a[4 + e])); } }
            return true;
        }
#pragma unroll
        for (int ai = 0; ai < 2; ++ai)
#pragma unroll
            for (int m = 0; m < 4; ++m)
#pragma unroll
                for (int bj = 0; bj < 2; ++bj) { const size_t off = (size_t)(row0 + ai * 128 + m * 16) * DM + u.pn * 256 + cl0 + bj * 128;
                    float b[8], r[8]; unpack8(*(const u32x4*)(gp + off), b);
#pragma unroll
                    for (int e = 0; e < 4; ++e) { r[e] = acc[ai][bj][m][0][e] * sigmoidf_(b[e]); r[4 + e] = acc[ai][bj][m][1][e] * sigmoidf_(b[4 + e]); }
                    *(u32x4*)(o + off) = pack8(r); }
        return false;
    }
};
struct EpiRes {
    unsigned short* o; const unsigned short* base; const float* gate;
    __device__ __forceinline__ bool operator()(f32x4 (&acc)[2][2][4][2], const Unit& u, int wr, int wc, int fr, int fq) const {
        const float* gp0 = gate + (size_t)((u.pm * 256) >> 12) * 12288 + u.pn * 256 + wc * 32 + 8 * fq;
        const f32x4 ga0 = *(const f32x4*)gp0, ga1 = *(const f32x4*)(gp0 + 4), gb0 = *(const f32x4*)(gp0 + 128), gb1 = *(const f32x4*)(gp0 + 132);
        EPI_LOOP_BEGIN const int col = u.pn * 256 + cl; const size_t off = (size_t)row * DM + col;
            const f32x4 g0 = bj ? gb0 : ga0, g1 = bj ? gb1 : ga1; f32x4 x0, x1; unpackh44(*(const u32x4*)(base + off), x0, x1);
            *(u32x4*)(o + off) = packh44(x0 + g0 * v0, x1 + g1 * v1); EPI_LOOP_END
        return false;
    }
};
struct EpiRes1 {
    unsigned short* o; const float* base; const float* mod; const float* n2w; bf16_t* xm; float* rowss;
    __device__ __forceinline__ bool operator()(f32x4 (&acc)[2][2][4][2], const Unit& u, int wr, int wc, int fr, int fq) const {
        const int row0 = u.pm * 256 + wr * 64 + fr, cl0 = wc * 32 + 8 * fq; const float* mr = mod + (size_t)(row0 >> 12) * 12288;
#pragma unroll
        for (int ai = 0; ai < 2; ++ai)
#pragma unroll
            for (int m = 0; m < 4; ++m) { const int row = row0 + ai * 128 + m * 16; float ss = 0.f;
#pragma unroll
                for (int bj = 0; bj < 2; ++bj) { const int col = u.pn * 256 + cl0 + bj * 128; const size_t off = (size_t)row * DM + col;
                    const f32x4 g0 = *(const f32x4*)(mr + 2 * DM + col), g1 = *(const f32x4*)(mr + 2 * DM + col + 4), x0 = *(const f32x4*)(base + off), x1 = *(const f32x4*)(base + off + 4);
                    const f32x4 r0 = x0 + g0 * acc[ai][bj][m][0], r1 = x1 + g1 * acc[ai][bj][m][1];
                    *(u32x4*)(o + off) = packh44(r0, r1);
                    ss += (r0.x * r0.x + r0.y * r0.y) + (r0.z * r0.z + r0.w * r0.w) + (r1.x * r1.x + r1.y * r1.y) + (r1.z * r1.z + r1.w * r1.w);
                    const f32x4 w0 = *(const f32x4*)(n2w + col) * (*(const f32x4*)(mr + 4 * DM + col) + 1.0f), w1 = *(const f32x4*)(n2w + col + 4) * (*(const f32x4*)(mr + 4 * DM + col + 4) + 1.0f);
                    *(u32x4*)(xm + off) = pack44(r0 * w0, r1 * w1); }
                ss += __shfl_xor(ss, 16); ss += __shfl_xor(ss, 32);
                if (fq == 0) atomicAdd(rowss + row, ss); }
        return false;
    }
};
struct EpiUp {
    bf16_t* a; bf16_t* g; const float* rowss; const float* bias2;
    __device__ __forceinline__ bool operator()(f32x4 (&acc)[2][2][4][2], const Unit& u, int wr, int wc, int fr, int fq) const {
        bf16_t* base = (u.pn < 22) ? a + u.pn * 256 : g + (u.pn - 22) * 256;
        const int row0 = u.pm * 256 + wr * 64 + fr, cl0 = wc * 32 + 8 * fq; const float* bb = bias2 + (size_t)(row0 >> 12) * (2 * DFF) + u.pn * 256 + cl0;
        const f32x4 b00 = *(const f32x4*)bb, b01 = *(const f32x4*)(bb + 4), b10 = *(const f32x4*)(bb + 128), b11 = *(const f32x4*)(bb + 132);
#pragma unroll
        for (int ai = 0; ai < 2; ++ai)
#pragma unroll
            for (int m = 0; m < 4; ++m) { const int row = row0 + ai * 128 + m * 16; const float rstd = rsqrtf(rowss[row] * (1.0f / DM) + EPS);
                *(u32x4*)(base + (size_t)row * DFF + cl0) = pack44(acc[ai][0][m][0] * rstd + b00, acc[ai][0][m][1] * rstd + b01);
                *(u32x4*)(base + (size_t)row * DFF + cl0 + 128) = pack44(acc[ai][1][m][0] * rstd + b10, acc[ai][1][m][1] * rstd + b11); }
        return false;
    }
};

#define LDS_WAIT() asm volatile("s_waitcnt lgkmcnt(0)" ::: "memory")

__device__ __forceinline__ void transpose_item(const float* W, int N, int k0, int n0, bf16_t* WT, int ldt, int dst_row0, float* scr, int lane) {
    float tv[32];
#pragma unroll
    for (int i = 0; i < 32; ++i) tv[i] = W[(size_t)(k0 + 2 * i + (lane >> 5)) * N + n0 + (lane & 31)];
#pragma unroll
    for (int i = 0; i < 32; ++i) scr[(2 * i + (lane >> 5)) * 33 + (lane & 31)] = tv[i];
    LDS_WAIT();
    const int c = lane & 7;
#pragma unroll
    for (int j = 0; j < 4; ++j) { const int n = (lane >> 3) + 8 * j; const float* s = scr + (8 * c) * 33 + n;
        u32x4 o; o.x = pk2(s[0 * 33], s[1 * 33]); o.y = pk2(s[2 * 33], s[3 * 33]); o.z = pk2(s[4 * 33], s[5 * 33]); o.w = pk2(s[6 * 33], s[7 * 33]);
        *(u32x4*)(WT + (size_t)(dst_row0 + n) * ldt + k0 + 8 * c) = o; }
    LDS_WAIT();
}

__device__ __forceinline__ void phase_prologue(const Params& p, unsigned char* smem) {
    const int tid = threadIdx.x, lane = tid & 63, wave = tid >> 6;
    const int gtid = blockIdx.x * 512 + tid, NT = gridDim.x * 512;
    float* sc = (float*)smem;
    for (int i = tid; i < 5 * DM; i += 512) { const int r = i >> 11, k = i & 2047; const float v = (r < 4) ? p.in[1][r * DM + k] : p.in[3][k]; sc[i] = v / (1.0f + expf(-v)); }
    __syncthreads();
    float* mod = (float*)(p.ws + OFF_MOD);
    for (int task = gtid; task < 3072 * 42; task += NT) {
        const int cq = task % 3072, ks = task / 3072, k0 = ks * 49, kn = min(49, DM - k0);
        f32x4 a0 = {0.f, 0.f, 0.f, 0.f}, a1 = a0, a2 = a0, a3 = a0, a4 = a0;
        const float* wp = p.in[4] + (size_t)k0 * 12288 + cq * 4;
#pragma unroll 7
        for (int kk = 0; kk < kn; ++kk) { const f32x4 w = *(const f32x4*)(wp + (size_t)kk * 12288); const int k = k0 + kk;
            a0 += sc[k] * w; a1 += sc[DM + k] * w; a2 += sc[2 * DM + k] * w; a3 += sc[3 * DM + k] * w; a4 += sc[4 * DM + k] * w; }
        if (ks == 0) { const f32x4 b = *(const f32x4*)(p.in[5] + cq * 4); a0 += b; a1 += b; a2 += b; a3 += b; a4 += b; }
#pragma unroll
        for (int e = 0; e < 4; ++e) { atomicAdd(mod + 0 * 12288 + cq * 4 + e, a0[e]); atomicAdd(mod + 1 * 12288 + cq * 4 + e, a1[e]); atomicAdd(mod + 2 * 12288 + cq * 4 + e, a2[e]);
            atomicAdd(mod + 3 * 12288 + cq * 4 + e, a3[e]); atomicAdd(mod + 4 * 12288 + cq * 4 + e, a4[e]); }
    }
    __syncthreads();
    float* scr = (float*)smem + wave * (64 * 33);
    bf16_t* WINT = (bf16_t*)((unsigned char*)p.out + OUT_WINT);
    const int gw = blockIdx.x * 8 + wave, NGW = gridDim.x * 8;
    constexpr int I_IN = 32 * (NIN / 32), I_SQ = 32 * 64, I_UP = 32 * (2 * DFF / 32), I_DN = (DFF / 64) * 64;
    constexpr int NITEMS = I_IN + I_SQ + I_UP;
    (void)I_DN;
    for (int it = gw; it < NITEMS; it += NGW) {
        int r = it;
        if (r < I_IN) { const int nblk = NIN / 32, kb = r / nblk, nb = r % nblk, n0 = 32 * nb; const int drow = (n0 >= 64) ? n0 - 64 : 12288 + n0;
            transpose_item(p.in[7], NIN, 64 * kb, n0, WINT, DM, drow, scr, lane); continue; } r -= I_IN;
        if (r < I_SQ) { transpose_item(p.in[17], DM, 64 * (r / 64), 32 * (r % 64), (bf16_t*)(p.ws + OFF_WPO), DM, 32 * (r % 64), scr, lane); continue; } r -= I_SQ;
        { const int nblk = 2 * DFF / 32; transpose_item(p.in[20], 2 * DFF, 64 * (r / nblk), 32 * (r % nblk), (bf16_t*)(p.ws + OFF_WUP), DM, 32 * (r % nblk), scr, lane); }
    }
    for (int i = gtid; i < 2048 * 64; i += NT) { const int row = i >> 6, o8 = (i & 63) * 8; float w[8], s[8], o[8]; load8f(p.in[15] + (size_t)row * 512 + o8, w); load8f(p.in[16] + (row >> 9) * 512 + o8, s);
#pragma unroll
        for (int e = 0; e < 8; ++e) o[e] = w[e] * s[e];
        *(u32x4*)((bf16_t*)(p.ws + OFF_WPW) + (size_t)row * 512 + o8) = pack8(o); }
    { u32x4* z = (u32x4*)(WINT + (size_t)NIN * DM); const u32x4 zero = {0u, 0u, 0u, 0u};
      for (int i = gtid; i < (NINP - NIN) * DM / 8; i += NT) z[i] = zero; }
}

__device__ __forceinline__ void phase_late_weights(const Params& p, unsigned char* smem, int widx, int nw) {
    const int lane = threadIdx.x & 63, wave = threadIdx.x >> 6;
    float* scr = (float*)smem + wave * (64 * 33);
    constexpr int I_SQ = 32 * 64, I_DN = (DFF / 64) * 64;
    for (int it = widx * 8 + wave; it < 2 * I_SQ + I_DN; it += nw * 8) {
        int r = it;
        if (r < I_SQ) { transpose_item(p.in[14], DM, 64 * (r / 64), 32 * (r % 64), (bf16_t*)(p.ws + OFF_WSSD), DM, 32 * (r % 64), scr, lane); continue; } r -= I_SQ;
        if (r < I_SQ) { transpose_item(p.in[18], DM, 64 * (r / 64), 32 * (r % 64), (bf16_t*)(p.ws + OFF_WO), DM, 32 * (r % 64), scr, lane); continue; } r -= I_SQ;
        { transpose_item(p.in[23], DM, 64 * (r / 64), 32 * (r % 64), (bf16_t*)(p.ws + OFF_WDN), DFF, 32 * (r % 64), scr, lane); }
    }
}

__device__ __forceinline__ void phase_modulate(const float* src_lat, const float* src_ctx, int nrows, const float* normw, const float* mod, int shidx, int scidx, bf16_t* dst) {
    const int lane = threadIdx.x & 63, rpb = (nrows + (int)gridDim.x - 1) / (int)gridDim.x, rend = min(nrows, ((int)blockIdx.x + 1) * rpb), gw = blockIdx.x * rpb + (threadIdx.x >> 6), NGW = 8;
    f32x4 v[8], wsc[8], shv[8]; int cur_mi = -1;
    if (gw < rend) { const float* xr = (gw < MLAT) ? src_lat + (size_t)gw * DM : src_ctx + (size_t)(gw - MLAT) * DM;
#pragma unroll
        for (int j = 0; j < 8; ++j) v[j] = *(const f32x4*)(xr + 4 * (lane + 64 * j)); }
    for (int row = gw; row < rend; row += NGW) {
        f32x4 nv[8]; const int nrow = row + NGW;
        if (nrow < rend) { const float* xr = (nrow < MLAT) ? src_lat + (size_t)nrow * DM : src_ctx + (size_t)(nrow - MLAT) * DM;
#pragma unroll
            for (int j = 0; j < 8; ++j) nv[j] = *(const f32x4*)(xr + 4 * (lane + 64 * j)); }
        const int mi = (row < MLAT) ? (row >> 12) : 4;
        if (mi != cur_mi) { cur_mi = mi; const float* mr = mod + (size_t)mi * 12288;
#pragma unroll
            for (int j = 0; j < 8; ++j) { const int col = 4 * (lane + 64 * j); wsc[j] = *(const f32x4*)(normw + col) * (*(const f32x4*)(mr + scidx * DM + col) + 1.0f); shv[j] = *(const f32x4*)(mr + shidx * DM + col); } }
        float s = 0.f;
#pragma unroll
        for (int j = 0; j < 8; ++j) s += (v[j].x * v[j].x + v[j].y * v[j].y) + (v[j].z * v[j].z + v[j].w * v[j].w);
        const float rstd = rsqrtf(wave_sum(s) * (1.0f / DM) + EPS);
#pragma unroll
        for (int j = 0; j < 8; ++j) { const int col = 4 * (lane + 64 * j);
            const f32x4 o = (v[j] * rstd) * wsc[j] + shv[j];
            u32x2 pk; pk.x = pk2(o.x, o.y); pk.y = pk2(o.z, o.w); *(u32x2*)(dst + (size_t)row * DM + col) = pk; }
        if (nrow < rend) {
#pragma unroll
            for (int j = 0; j < 8; ++j) v[j] = nv[j]; }
    }
}

__device__ __forceinline__ void phase_conv_pool(const Params& p, unsigned char* smem) {
    const int tid = threadIdx.x, gtid = blockIdx.x * 512 + tid, NT = gridDim.x * 512;
    const bf16_t* raw = (const bf16_t*)(p.ws + OFF_XBC); const float* cw = p.in[8]; const float* cb = p.in[9];
    bf16_t* xcl = (bf16_t*)p.out; bf16_t* xcc = (bf16_t*)(p.ws + OFF_XC);
    const u32x4 zero = {0u, 0u, 0u, 0u};
    {
        const int col = tid * 8, tpb = (MLAT + (int)gridDim.x - 1) / (int)gridDim.x, t0 = blockIdx.x * tpb, t1 = min(t0 + tpb, MLAT);
        float w0[8], w1[8], w2[8], bb[8]; load8f(cw + col, w0); load8f(cw + 4096 + col, w1); load8f(cw + 8192 + col, w2); load8f(cb + col, bb);
        if (t0 < t1) {
            const bf16_t* src = raw + (size_t)t0 * 4096 + col; bf16_t* dst = xcl + (size_t)t0 * 4096 + col;
            float x0[8], x1[8];
            unpack8(((t0 & (SEQ - 1)) != 0) ? *(const u32x4*)(src - 4096) : zero, x0); unpack8(*(const u32x4*)src, x1);
#pragma unroll 4
            for (int t = t0; t < t1; ++t) {
                const u32x4 r2 = (((t + 1) & (SEQ - 1)) != 0) ? __builtin_nontemporal_load((const u32x4*)(src + 4096)) : zero;
                float x2[8], o[8]; unpack8(r2, x2);
#pragma unroll
                for (int e = 0; e < 8; ++e) o[e] = siluf_(x0[e] * w0[e] + bb[e] + x1[e] * w1[e] + x2[e] * w2[e]);
                *(u32x4*)dst = pack8(o);
#pragma unroll
                for (int e = 0; e < 8; ++e) { x0[e] = x1[e]; x1[e] = x2[e]; }
                src += 4096; dst += 4096;
            }
        }
    }
    for (int idx = gtid; idx < MCTX * 384; idx += NT) {
        const int t = idx / 384, col = (idx % 384) * 8, tl = t & (CTXL - 1); const bf16_t* src = raw + (size_t)(MLAT + t) * 4096 + col; bf16_t* dst = xcc + (size_t)t * 4096 + col;
        const u32x4 r1 = *(const u32x4*)src; const u32x4 r0 = (tl > 0) ? *(const u32x4*)(src - 4096) : zero; const u32x4 r2 = (tl < CTXL - 1) ? *(const u32x4*)(src + 4096) : zero;
        float x0[8], x1[8], x2[8], w0[8], w1[8], w2[8], b[8], o[8];
        unpack8(r0, x0); unpack8(r1, x1); unpack8(r2, x2); load8f(cw + col, w0); load8f(cw + 4096 + col, w1); load8f(cw + 8192 + col, w2); load8f(cb + col, b);
#pragma unroll
        for (int e = 0; e < 8; ++e) o[e] = siluf_(x0[e] * w0[e] + b[e] + x1[e] * w1[e] + x2[e] * w2[e]);
        *(u32x4*)dst = pack8(o);
    }
    const bf16_t* V = (const bf16_t*)(p.ws + OFF_V); bf16_t* P = (bf16_t*)(p.ws + OFF_P);
    PG8_LAS unsigned char* L = (PG8_LAS unsigned char*)smem;
    for (int it = blockIdx.x; it < (MLAT / 64) * 4; it += gridDim.x) {
        const int gr = it >> 2, g = it & 3, hw = 1 << g;
        const bf16_t* base = V + (size_t)gr * 64 * DM + g * 512;
        __syncthreads();
#pragma unroll
        for (int j = 0; j < 8; ++j) { const int piece = tid + 512 * j, row = piece >> 6, pc = piece & 63; *(PG8_LAS u32x4*)(L + row * 1024 + pc * 16) = *(const u32x4*)(base + (size_t)row * DM + pc * 8); }
        __syncthreads();
        const int cvv = tid & 63, tq = tid >> 6;
        float s[8];
#pragma unroll
        for (int e = 0; e < 8; ++e) s[e] = 0.f;
        for (int jj = max(tq * 8 - hw, 0); jj < min(tq * 8 + hw, 64); ++jj) { float x[8]; unpack8(*(const PG8_LAS u32x4*)(L + jj * 1024 + cvv * 16), x);
#pragma unroll
            for (int e = 0; e < 8; ++e) s[e] += x[e]; }
        for (int i = 0; i < 8; ++i) { const int tc = tq * 8 + i, lo = max(tc - hw, 0), hi = min(tc + hw, 64);
            float me[8], o[8];
            if (i > 0) {
                const int ad = tc - 1 + hw, sb = tc - 1 - hw;
                if (ad < 64) { float x[8]; unpack8(*(const PG8_LAS u32x4*)(L + ad * 1024 + cvv * 16), x);
#pragma unroll
                    for (int e = 0; e < 8; ++e) s[e] += x[e]; }
                if (sb >= 0) { float x[8]; unpack8(*(const PG8_LAS u32x4*)(L + sb * 1024 + cvv * 16), x);
#pragma unroll
                    for (int e = 0; e < 8; ++e) s[e] -= x[e]; }
            }
            unpack8(*(const PG8_LAS u32x4*)(L + tc * 1024 + cvv * 16), me);
            const float inv = 1.0f / (float)(hi - lo);
#pragma unroll
            for (int e = 0; e < 8; ++e) o[e] = s[e] * inv - me[e];
            *(u32x4*)(P + (size_t)(gr * 64 + tc) * DM + g * 512 + cvv * 8) = pack8(o); }
    }
}

__device__ __forceinline__ void phase_ssd_scan(const Params& p, unsigned char* smem) {
    const int tid = threadIdx.x, lane = tid & 63, wave = tid >> 6;
    float* sX = (float*)smem;
    float* sB = sX + 32 * 64;
    float* sC = sB + 32 * 128;
    float* sY = sC + 32 * 128;
    float* sdt = sY + 8 * 32 * 64;
    const bf16_t* xcl = (const bf16_t*)p.out; const bf16_t* xcc = (const bf16_t*)(p.ws + OFF_XC); const float* DT = (const float*)(p.ws + OFF_DT);
    for (int item = blockIdx.x; item < 256; item += gridDim.x) {
        const int xcd = item & 7, slot = item >> 3, gid = xcd * 4 + (slot >> 3), mem = slot & 7;
        const int b = gid >> 3, g = gid & 7, dir = mem >> 2, h = g * 4 + (mem & 3);
        const float Ah = -expf(p.in[11][dir * 32 + h]), dsk = p.in[12][dir * 32 + h];
        bf16_t* Y = (bf16_t*)(p.ws + (dir ? OFF_YB : OFF_YF));
        float hs[16];
#pragma unroll
        for (int j = 0; j < 16; ++j) hs[j] = 0.f;
        for (int ck = 0; ck < (CTXL + SEQ) / 32; ++ck) {
            const bool isctx = ck < CTXL / 32;
            __syncthreads();
            {   const int i = tid >> 4, q = tid & 15;
                const int s = ck * 32 + i;
                int tok; const bf16_t* rowp; size_t drow;
                if (isctx) { tok = dir ? (CTXL - 1 - s) : s; rowp = xcc + (size_t)(b * CTXL + tok) * 4096; drow = (size_t)(MLAT + b * CTXL + tok); }
                else { const int s2 = s - CTXL; tok = dir ? (SEQ - 1 - s2) : s2; rowp = xcl + (size_t)(b * SEQ + tok) * 4096; drow = (size_t)(b * SEQ + tok); }
                { const u32x2 xv = *(const u32x2*)(rowp + h * 64 + q * 4); float* d = sX + i * 64 + q * 4; d[0] = bflo(xv.x); d[1] = bfhi(xv.x); d[2] = bflo(xv.y); d[3] = bfhi(xv.y); }
                { float o[8]; unpack8(*(const u32x4*)(rowp + 2048 + g * 128 + q * 8), o); float* d = sB + i * 128 + q * 8;
#pragma unroll
                  for (int e = 0; e < 8; ++e) d[e] = o[e]; }
                if (!isctx) { float o[8]; unpack8(*(const u32x4*)(rowp + 3072 + g * 128 + q * 8), o); float* d = sC + i * 128 + q * 8;
#pragma unroll
                  for (int e = 0; e < 8; ++e) d[e] = o[e]; }
                if (q == 0) { const float dt = DT[drow * 64 + dir * 32 + h]; sdt[i] = dt; sdt[32 + i] = expf(dt * Ah); }
            }
            __syncthreads();
            for (int i = 0; i < 32; ++i) {
                const float dt = sdt[i], dA = sdt[32 + i], xd = sX[i * 64 + lane] * dt;
                const float* bp = sB + i * 128 + wave * 16; const float* cp = sC + i * 128 + wave * 16;
                float yp = 0.f;
#pragma unroll
                for (int j = 0; j < 16; ++j) { hs[j] = hs[j] * dA + xd * bp[j]; yp += cp[j] * hs[j]; }
                sY[(wave * 32 + i) * 64 + lane] = yp;
            }
            __syncthreads();
            if (!isctx) {
                const int i = tid >> 4, q = tid & 15, s2 = ck * 32 + i - CTXL, tok = dir ? (SEQ - 1 - s2) : s2;
                float o[4];
#pragma unroll
                for (int e = 0; e < 4; ++e) { const int pp = q * 4 + e; float a = dsk * sX[i * 64 + pp];
#pragma unroll
                    for (int w = 0; w < 8; ++w) a += sY[(w * 32 + i) * 64 + pp];
                    o[e] = a; }
                u32x2 pk; pk.x = pk2(o[0], o[1]); pk.y = pk2(o[2], o[3]);
                *(u32x2*)(Y + (size_t)(b * SEQ + tok) * DM + h * 64 + q * 4) = pk;
            }
        }
    }
}


constexpr int SS_LD = 272;
constexpr int SS_C = 0, SS_B = 34816, SS_BT = 69632, SS_XT = 104448, SS_HB = 121856, SS_CS = 139264, SS_DT = 139776, SS_HB2 = 140288, SS_END = 157696;
__device__ __forceinline__ void phase_ssd_mfma(const Params& p, unsigned char* smem) {
    using pg8::bf16x8;
    const int tid = threadIdx.x, lane = tid & 63, wave = __builtin_amdgcn_readfirstlane(tid >> 6), fr = lane & 15, fq = lane >> 4;
    PG8_LAS unsigned char* L = (PG8_LAS unsigned char*)smem;
    PG8_LAS float* scs = (PG8_LAS float*)(L + SS_CS); PG8_LAS float* sdt = (PG8_LAS float*)(L + SS_DT);
    const bf16_t* xcl = (const bf16_t*)p.out; const bf16_t* xcc = (const bf16_t*)(p.ws + OFF_XC); const float* DT = (const float*)(p.ws + OFF_DT);
#define SSD_ROW(s_, rowp_, drow_) do { if (isctx) { const int tk_ = dir ? (CTXL - 1 - (sbase + (s_))) : (sbase + (s_)); const int gr_ = b * CTXL + tk_; rowp_ = xcc + (size_t)gr_ * 4096; drow_ = MLAT + gr_; } \
        else { const int tk_ = dir ? (SEQ - 1 - (sbase + (s_))) : (sbase + (s_)); const int gr_ = b * SEQ + tk_; rowp_ = xcl + (size_t)gr_ * 4096; drow_ = gr_; } } while (0)
#define SSD_FRAG(off_, row_, ks_) (*(const PG8_LAS bf16x8*)(L + (off_) + (row_) * SS_LD + (ks_) * 64 + fq * 16))
    for (int item = blockIdx.x; item < 256; item += gridDim.x) {
        const int xcd = item & 7, slot = item >> 3, gid = xcd * 4 + (slot >> 3), mem = slot & 7;
        const int b = gid >> 3, g = gid & 7, dir = mem >> 2, h = g * 4 + (mem & 3);
        const float Ah = -expf(p.in[11][dir * 32 + h]), dsk = p.in[12][dir * 32 + h];
        bf16_t* Y = (bf16_t*)(p.ws + (dir ? OFF_YB : OFF_YF));
        f32x4 H[4];
#pragma unroll
        for (int j = 0; j < 4; ++j) H[j] = (f32x4){0.f, 0.f, 0.f, 0.f};
        const int hi_half = wave & 1, sm = lane + 64 * hi_half, q4 = wave >> 1;
        float dt_lo, dt_hi; u32x4 xv[2], bv[4], cv[4];
#define SSD_LOAD(ckk_) do { const int ck_ = (ckk_); const bool isctx = ck_ < CTXL / 128; const int sbase = isctx ? ck_ * 128 : (ck_ - CTXL / 128) * 128; \
            const bf16_t *rl_, *rh_; int dl_, dh_; SSD_ROW(lane, rl_, dl_); SSD_ROW(lane + 64, rh_, dh_); \
            dt_lo = DT[(size_t)dl_ * 64 + dir * 32 + h]; dt_hi = DT[(size_t)dh_ * 64 + dir * 32 + h]; const bf16_t* rp_ = hi_half ? rh_ : rl_; \
            _Pragma("unroll") for (int j_ = 0; j_ < 2; ++j_) xv[j_] = *(const u32x4*)(rp_ + h * 64 + 8 * (q4 + 4 * j_)); \
            _Pragma("unroll") for (int j_ = 0; j_ < 4; ++j_) bv[j_] = *(const u32x4*)(rp_ + 2048 + g * 128 + 8 * (q4 + 4 * j_)); \
            if (!isctx) { _Pragma("unroll") for (int j_ = 0; j_ < 4; ++j_) { const bf16_t* rc_; int dc_; SSD_ROW((tid >> 4) + 32 * j_, rc_, dc_); (void)dc_; cv[j_] = *(const u32x4*)(rc_ + 3072 + g * 128 + (tid & 15) * 8); } } } while (0)
#define LBAR() do { asm volatile("s_waitcnt lgkmcnt(0)" ::: "memory"); __builtin_amdgcn_s_barrier(); asm volatile("" ::: "memory"); } while (0)
        SSD_LOAD(0);
        for (int ck = 0; ck < (CTXL + SEQ) / 128; ++ck) {
            const bool isctx = ck < CTXL / 128;
            const int sbase = isctx ? ck * 128 : (ck - CTXL / 128) * 128;
            LBAR();
            float c_lo = dt_lo * Ah, c_hi = dt_hi * Ah;
            c_lo = wave_incl_scan(c_lo); c_hi = wave_incl_scan(c_hi);
            c_hi += __int_as_float(__builtin_amdgcn_readlane(__float_as_int(c_lo), 63));
            const float c_last = __int_as_float(__builtin_amdgcn_readlane(__float_as_int(c_hi), 63));
            if (wave == 0) { scs[lane] = c_lo; scs[lane + 64] = c_hi; sdt[lane] = dt_lo; sdt[lane + 64] = dt_hi; }
            const float wsc = (hi_half ? dt_hi : dt_lo) * __expf(c_last - (hi_half ? c_hi : c_lo));
#pragma unroll
            for (int j = 0; j < 2; ++j) { const int p0 = 8 * (q4 + 4 * j); const u32x4 v = xv[j];
                PG8_LAS unsigned char* d = L + SS_XT + p0 * SS_LD + sm * 2;
                *(PG8_LAS unsigned short*)(d + 0 * SS_LD) = (unsigned short)(v.x & 0xffffu); *(PG8_LAS unsigned short*)(d + 1 * SS_LD) = (unsigned short)(v.x >> 16);
                *(PG8_LAS unsigned short*)(d + 2 * SS_LD) = (unsigned short)(v.y & 0xffffu); *(PG8_LAS unsigned short*)(d + 3 * SS_LD) = (unsigned short)(v.y >> 16);
                *(PG8_LAS unsigned short*)(d + 4 * SS_LD) = (unsigned short)(v.z & 0xffffu); *(PG8_LAS unsigned short*)(d + 5 * SS_LD) = (unsigned short)(v.z >> 16);
                *(PG8_LAS unsigned short*)(d + 6 * SS_LD) = (unsigned short)(v.w & 0xffffu); *(PG8_LAS unsigned short*)(d + 7 * SS_LD) = (unsigned short)(v.w >> 16); }
#pragma unroll
            for (int j = 0; j < 4; ++j) { const int n0 = 8 * (q4 + 4 * j); const u32x4 v = bv[j];
                if (!isctx) *(PG8_LAS u32x4*)(L + SS_B + sm * SS_LD + n0 * 2) = v;
                float f[8]; unpack8(v, f);
                PG8_LAS unsigned char* d = L + SS_BT + n0 * SS_LD + sm * 2;
#pragma unroll
                for (int e = 0; e < 8; e += 2) { const unsigned w2 = pk2(f[e] * wsc, f[e + 1] * wsc);
                    *(PG8_LAS unsigned short*)(d + e * SS_LD) = (unsigned short)(w2 & 0xffffu); *(PG8_LAS unsigned short*)(d + (e + 1) * SS_LD) = (unsigned short)(w2 >> 16); } }
            if (!isctx) {
#pragma unroll
                for (int j = 0; j < 4; ++j) *(PG8_LAS u32x4*)(L + SS_C + ((tid >> 4) + 32 * j) * SS_LD + (tid & 15) * 16) = cv[j];
            }
            if (ck + 1 < (CTXL + SEQ) / 128) SSD_LOAD(ck + 1);
            LBAR();
            f32x4 aY[4];
#define SB0() __builtin_amdgcn_sched_barrier(0)
            const int hb_rd = (ck & 1) ? SS_HB2 : SS_HB, hb_wr = (ck & 1) ? SS_HB : SS_HB2;
            const int l = 16 * wave + fr;
            if (!isctx) {
                bf16x8 cf[4];
#pragma unroll
                for (int ks = 0; ks < 4; ++ks) cf[ks] = SSD_FRAG(SS_C, l, ks);
#pragma unroll
                for (int ph = 0; ph < 2; ++ph) { bf16x8 hb[8];
#pragma unroll
                    for (int q = 0; q < 8; ++q) hb[q] = SSD_FRAG(hb_rd, 16 * (2 * ph + (q >> 2)) + fr, q & 3);
                    SB0();
                    f32x4 a0 = {0.f, 0.f, 0.f, 0.f}, a1 = a0;
#pragma unroll
                    for (int ks = 0; ks < 4; ++ks) { a0 = __builtin_amdgcn_mfma_f32_16x16x32_bf16(hb[ks], cf[ks], a0, 0, 0, 0); a1 = __builtin_amdgcn_mfma_f32_16x16x32_bf16(hb[4 + ks], cf[ks], a1, 0, 0, 0); }
                    aY[2 * ph] = a0; aY[2 * ph + 1] = a1;
                    SB0(); }
                const float csl = scs[l];
#pragma unroll
                for (int sp = 0; sp < 4; ++sp) {
                    if (2 * sp <= wave) {
                        bf16x8 bq[4], br[4];
#pragma unroll
                        for (int q = 0; q < 4; ++q) bq[q] = SSD_FRAG(SS_B, 16 * (2 * sp) + fr, q);
#pragma unroll
                        for (int q = 0; q < 4; ++q) br[q] = SSD_FRAG(SS_B, 16 * (2 * sp + 1) + fr, q);
                        const int s0 = 32 * sp + 4 * fq;
                        const f32x4 csA = *(const PG8_LAS f32x4*)(scs + s0), dtA = *(const PG8_LAS f32x4*)(sdt + s0), csB = *(const PG8_LAS f32x4*)(scs + s0 + 16), dtB = *(const PG8_LAS f32x4*)(sdt + s0 + 16);
                        SB0();
                        f32x4 a0 = {0.f, 0.f, 0.f, 0.f}, a1 = a0;
#pragma unroll
                        for (int ks = 0; ks < 4; ++ks) a0 = __builtin_amdgcn_mfma_f32_16x16x32_bf16(bq[ks], cf[ks], a0, 0, 0, 0);
#pragma unroll
                        for (int ks = 0; ks < 4; ++ks) a1 = __builtin_amdgcn_mfma_f32_16x16x32_bf16(br[ks], cf[ks], a1, 0, 0, 0);
                        float m0[4], m1[4];
#pragma unroll
                        for (int r = 0; r < 4; ++r) { const float e0 = __expf(fminf(csl - csA[r], 0.f)) * dtA[r], e1 = __expf(fminf(csl - csB[r], 0.f)) * dtB[r];
                            m0[r] = (s0 + r <= l) ? a0[r] * e0 : 0.f; m1[r] = (s0 + 16 + r <= l) ? a1[r] * e1 : 0.f; }
                        u32x2 w0, w1; w0.x = pk2(m0[0], m0[1]); w0.y = pk2(m0[2], m0[3]); w1.x = pk2(m1[0], m1[1]); w1.y = pk2(m1[2], m1[3]);
                        *(PG8_LAS u32x2*)(L + SS_C + l * SS_LD + s0 * 2) = w0; *(PG8_LAS u32x2*)(L + SS_C + l * SS_LD + (s0 + 16) * 2) = w1;
                        SB0();
                    }
                }
            }
            asm volatile("" ::: "memory");
            {
                const float dec = __expf(c_last); bf16x8 af[4];
#pragma unroll
                for (int ks = 0; ks < 4; ++ks) af[ks] = SSD_FRAG(SS_BT, l, ks);
#pragma unroll
                for (int ph = 0; ph < 2; ++ph) { bf16x8 xt[8];
#pragma unroll
                    for (int q = 0; q < 8; ++q) xt[q] = SSD_FRAG(SS_XT, 16 * (2 * ph + (q >> 2)) + fr, q & 3);
                    SB0();
                    f32x4 a0 = H[2 * ph] * dec, a1 = H[2 * ph + 1] * dec;
#pragma unroll
                    for (int ks = 0; ks < 4; ++ks) { a0 = __builtin_amdgcn_mfma_f32_16x16x32_bf16(af[ks], xt[ks], a0, 0, 0, 0); a1 = __builtin_amdgcn_mfma_f32_16x16x32_bf16(af[ks], xt[4 + ks], a1, 0, 0, 0); }
                    H[2 * ph] = a0; H[2 * ph + 1] = a1;
                    SB0(); }
                asm volatile("s_nop 15\n\ts_nop 7" : "+v"(H[0]), "+v"(H[1]), "+v"(H[2]), "+v"(H[3]));
#pragma unroll
                for (int pt = 0; pt < 4; ++pt) { u32x2 w; w.x = pk2(H[pt][0], H[pt][1]); w.y = pk2(H[pt][2], H[pt][3]); *(PG8_LAS u32x2*)(L + hb_wr + (16 * pt + fr) * SS_LD + (16 * wave + 4 * fq) * 2) = w; }
            }
            if (!isctx) {
                const float el = __expf(scs[l]);
                const int nks = ((16 * wave + 15) >> 5) + 1;
                const int tokl = dir ? (SEQ - 1 - (sbase + l)) : (sbase + l);
                bf16x8 mf[4];
#pragma unroll
                for (int ks = 0; ks < 4; ++ks) mf[ks] = SSD_FRAG(SS_C, l, (ks < nks) ? ks : 0);
#pragma unroll
                for (int ph = 0; ph < 2; ++ph) { bf16x8 xt[8]; unsigned xb[8];
#pragma unroll
                    for (int q = 0; q < 8; ++q) xt[q] = SSD_FRAG(SS_XT, 16 * (2 * ph + (q >> 2)) + fr, ((q & 3) < nks) ? (q & 3) : 0);
#pragma unroll
                    for (int q = 0; q < 8; ++q) xb[q] = *(const PG8_LAS unsigned short*)(L + SS_XT + (16 * (2 * ph + (q >> 2)) + 4 * fq + (q & 3)) * SS_LD + l * 2);
                    SB0();
#pragma unroll
                    for (int hh = 0; hh < 2; ++hh) { const int pt = 2 * ph + hh; f32x4 a = aY[pt] * el;
#pragma unroll
                        for (int ks = 0; ks < 4; ++ks) if (ks < nks) a = __builtin_amdgcn_mfma_f32_16x16x32_bf16(xt[hh * 4 + ks], mf[ks], a, 0, 0, 0);
#pragma unroll
                        for (int r = 0; r < 4; ++r) a[r] += dsk * __uint_as_float(xb[hh * 4 + r] << 16);
                        u32x2 w; w.x = pk2(a[0], a[1]); w.y = pk2(a[2], a[3]);
                        *(u32x2*)(Y + (size_t)(b * SEQ + tokl) * DM + h * 64 + 16 * pt + 4 * fq) = w; }
                    SB0(); }
            }
        }
        LBAR();
    }
#undef SSD_ROW
#undef SSD_FRAG
#undef SSD_LOAD
#undef LBAR
#undef SB0
}

__device__ __forceinline__ void phase_gate_norm(const Params& p) {
    const int lane = threadIdx.x & 63, rpb = (MLAT + (int)gridDim.x - 1) / (int)gridDim.x, rend = min(MLAT, ((int)blockIdx.x + 1) * rpb), gw = blockIdx.x * rpb + (threadIdx.x >> 6), NGW = 8;
    const bf16_t* YF = (const bf16_t*)(p.ws + OFF_YF); const bf16_t* YB = (const bf16_t*)(p.ws + OFF_YB); bf16_t* Z = (bf16_t*)(p.ws + OFF_Z); const float* nw = p.in[13];
    u32x4 ra[4], rb[4], rz[4];
    if (gw < rend) {
#pragma unroll
        for (int j = 0; j < 4; ++j) { const size_t off = (size_t)gw * DM + j * 512 + 8 * lane; ra[j] = __builtin_nontemporal_load((const u32x4*)(YF + off)); rb[j] = __builtin_nontemporal_load((const u32x4*)(YB + off)); rz[j] = __builtin_nontemporal_load((const u32x4*)(Z + off)); } }
    for (int row = gw; row < rend; row += NGW) {
        u32x4 na[4], nb[4], nz[4]; const int nrow = row + NGW;
        if (nrow < rend) {
#pragma unroll
            for (int j = 0; j < 4; ++j) { const size_t off = (size_t)nrow * DM + j * 512 + 8 * lane; na[j] = __builtin_nontemporal_load((const u32x4*)(YF + off)); nb[j] = __builtin_nontemporal_load((const u32x4*)(YB + off)); nz[j] = __builtin_nontemporal_load((const u32x4*)(Z + off)); } }
#pragma unroll
        for (int j = 0; j < 4; ++j) { const int col = j * 512 + 8 * lane; const size_t off = (size_t)row * DM + col;
            float a[8], b[8], z[8], w[8], o[8]; unpack8(ra[j], a); unpack8(rb[j], b); unpack8(rz[j], z); load8f(nw + col, w);
            float ss = 0.f;
#pragma unroll
            for (int e = 0; e < 8; ++e) { o[e] = (a[e] + b[e]) * siluf_(z[e]); ss += o[e] * o[e]; }
#pragma unroll
            for (int m = 1; m < 32; m <<= 1) ss += __shfl_xor(ss, m);
            const float rstd = rsqrtf(ss * (1.0f / 256.0f) + EPS);
#pragma unroll
            for (int e = 0; e < 8; ++e) o[e] = o[e] * rstd * w[e];
            *(u32x4*)(Z + off) = pack8(o); }
        if (nrow < rend) {
#pragma unroll
            for (int j = 0; j < 4; ++j) { ra[j] = na[j]; rb[j] = nb[j]; rz[j] = nz[j]; } }
    }
}

__device__ __forceinline__ void phase_ffn_act(const Params& p) {
    const int gtid = blockIdx.x * 512 + threadIdx.x, NT = gridDim.x * 512;
    bf16_t* A = (bf16_t*)(p.ws + OFF_UPA); const bf16_t* G = (const bf16_t*)(p.ws + OFF_UPG); const float* fw = p.in[21]; const float* fb = p.in[22];
    const u32x4 zero = {0u, 0u, 0u, 0u};
    constexpr int NCV = DFF / 8, NHL = NBATCH * 64 * 2;
    for (int task = gtid; task < NCV * NHL; task += NT) {
        const int cvi = task % NCV, hl = task / NCV, col = cvi * 8, bq = hl >> 7, gc = (hl >> 1) & 63, r0 = (hl & 1) * 32;
        float w0[8], w1[8], w2[8], b[8]; load8f(fw + col, w0); load8f(fw + DFF + col, w1); load8f(fw + 2 * DFF + col, w2); load8f(fb + col, b);
        const size_t rstride = (size_t)64 * DFF;
        size_t off = ((size_t)(bq * SEQ + r0 * 64 + gc)) * DFF + col;
        float x0[8], x1[8];
        unpack8((r0 > 0) ? *(const u32x4*)(G + off - rstride) : zero, x0); unpack8(*(const u32x4*)(G + off), x1);
#pragma unroll 4
        for (int r = r0; r < r0 + 32; ++r) {
            const u32x4 g2 = (r < 63) ? __builtin_nontemporal_load((const u32x4*)(G + off + rstride)) : zero;
            float x2[8], a[8], o[8];
            unpack8(g2, x2); unpack8(__builtin_nontemporal_load((const u32x4*)(A + off)), a);
#pragma unroll
            for (int e = 0; e < 8; e += 2) { f32x2 gv; gv.x = x0[e] * w0[e] + b[e] + x1[e] * w1[e] + x2[e] * w2[e]; gv.y = x0[e + 1] * w0[e + 1] + b[e + 1] + x1[e + 1] * w1[e + 1] + x2[e + 1] * w2[e + 1];
                const f32x2 ge = gelu_pk(gv); o[e] = ge.x * a[e]; o[e + 1] = ge.y * a[e + 1]; }
            *(u32x4*)(A + off) = pack8(o);
#pragma unroll
            for (int e = 0; e < 8; ++e) { x0[e] = x1[e]; x1[e] = x2[e]; }
            off += rstride;
        }
    }
}

__device__ __forceinline__ void phase_final_norm(const Params& p) {
    const int lane = threadIdx.x & 63, rpb = (MLAT + (int)gridDim.x - 1) / (int)gridDim.x, rend = min(MLAT, ((int)blockIdx.x + 1) * rpb), gw = blockIdx.x * rpb + (threadIdx.x >> 6), NGW = 8; const float* fw = p.in[24];
    const unsigned short* x2 = (const unsigned short*)(p.ws + OFF_UPG);
    u32x4 v[4]; f32x4 fwa[4], fwb[4];
#pragma unroll
    for (int j = 0; j < 4; ++j) { fwa[j] = *(const f32x4*)(fw + 8 * (lane + 64 * j)); fwb[j] = *(const f32x4*)(fw + 8 * (lane + 64 * j) + 4); }
    if (gw < rend) {
#pragma unroll
        for (int j = 0; j < 4; ++j) v[j] = __builtin_nontemporal_load((const u32x4*)(x2 + (size_t)gw * DM + 8 * (lane + 64 * j))); }
    for (int row = gw; row < rend; row += NGW) {
        u32x4 nv[4]; const int nrow = row + NGW;
        if (nrow < rend) {
#pragma unroll
            for (int j = 0; j < 4; ++j) nv[j] = __builtin_nontemporal_load((const u32x4*)(x2 + (size_t)nrow * DM + 8 * (lane + 64 * j))); }
        float* xr = p.out + (size_t)row * DM; float s = 0.f; f32x4 a[4], b[4];
#pragma unroll
        for (int j = 0; j < 4; ++j) { unpackh44(v[j], a[j], b[j]); s += (a[j].x * a[j].x + a[j].y * a[j].y) + (a[j].z * a[j].z + a[j].w * a[j].w) + (b[j].x * b[j].x + b[j].y * b[j].y) + (b[j].z * b[j].z + b[j].w * b[j].w); }
        const float rstd = rsqrtf(wave_sum(s) * (1.0f / DM) + EPS);
#pragma unroll
        for (int j = 0; j < 4; ++j) { const int col = 8 * (lane + 64 * j); *(f32x4*)(xr + col) = a[j] * rstd * fwa[j]; *(f32x4*)(xr + col + 4) = b[j] * rstd * fwb[j]; }
        if (nrow < rend) {
#pragma unroll
            for (int j = 0; j < 4; ++j) v[j] = nv[j]; }
    }
}

#define XB_TMO      128
#define XB_XCNT(j)  (256  + 64 * (j))
#define XB_XSUB(j)  (1280 + 64 * (j))
#define XB_XGEN(j)  (2304 + 64 * (j))
#define XB_TOP      3328
#define XB_TOPGEN   3392
#define XCD_BAR_WORDS 3456
#define XB_SPIN_CAP (1u << 20)
__device__ __forceinline__ unsigned xb_ld(unsigned* p)              { return __hip_atomic_load(p, __ATOMIC_RELAXED, __HIP_MEMORY_SCOPE_AGENT); }
__device__ __forceinline__ unsigned xb_add(unsigned* p, unsigned v) { return __hip_atomic_fetch_add(p, v, __ATOMIC_RELAXED, __HIP_MEMORY_SCOPE_AGENT); }
__device__ __forceinline__ unsigned xb_xcc_id() { return (unsigned)__builtin_amdgcn_s_getreg((3 << 11) | 20) & 0xFu; }
#define XB_SPIN(cond, bar) do { unsigned _sp = 0; while (cond) { __builtin_amdgcn_s_sleep(1); \
    if ((++_sp & 255u) == 0u) { if (xb_ld(&(bar)[XB_TMO])) break; if (_sp > XB_SPIN_CAP) { atomicAdd(&(bar)[XB_TMO], 1u); break; } } } } while (0)
struct XcdBarrier { unsigned* bar; unsigned x; volatile PG8_LAS unsigned* st; };
__device__ __forceinline__ XcdBarrier xcd_barrier_post(unsigned* bar, volatile PG8_LAS unsigned* st) {
    XcdBarrier b; b.bar = bar; b.x = xb_xcc_id(); b.st = st;
    if (threadIdx.x == 0) (void)xb_add(&bar[XB_XCNT(b.x)], 1u);
    return b;
}
__device__ __forceinline__ void xcd_barrier_complete(unsigned* bar, unsigned x, unsigned& nloc, unsigned& nx) {
    const unsigned G = gridDim.x * gridDim.y * gridDim.z;
    unsigned sum, cnt, mine, sp = 0u;
    for (;;) {
        sum = 0u; cnt = 0u; mine = 0u;
#pragma unroll
        for (unsigned j = 0; j < 16; ++j) { const unsigned c = xb_ld(&bar[XB_XCNT(j)]); sum += c; cnt += (c > 0u) ? 1u : 0u; mine = (j == x) ? c : mine; }
        if (sum == G) break;
        __builtin_amdgcn_s_sleep(1);
        if ((++sp & 255u) == 0u) { if (xb_ld(&bar[XB_TMO])) break; if (sp > XB_SPIN_CAP) { atomicAdd(&bar[XB_TMO], 1u); break; } }
    }
    nloc = mine > 0u ? mine : 1u; nx = cnt > 0u ? cnt : 1u;
}
__device__ __forceinline__ void xcd_barrier(const XcdBarrier& b) {
    asm volatile("s_waitcnt vmcnt(0)" ::: "memory");
    __syncthreads();
    if (threadIdx.x == 0) {
        unsigned* bar = b.bar;
        __builtin_amdgcn_s_waitcnt(0);
        unsigned nloc = b.st[0], nx = b.st[1];
        if (nloc == 0u) { xcd_barrier_complete(bar, b.x, nloc, nx); b.st[0] = nloc; b.st[1] = nx; }
        const unsigned old = xb_add(&bar[XB_XSUB(b.x)], 1u);
        const unsigned gen = old / nloc;
        if (old + 1u == (gen + 1u) * nloc) {
            __builtin_amdgcn_fence(__ATOMIC_RELEASE, "agent");
            asm volatile("s_waitcnt vmcnt(0)" ::: "memory");
            const unsigned og = xb_add(&bar[XB_TOP], 1u);
            const unsigned tg = og / nx;
            if (og + 1u == (tg + 1u) * nx) xb_add(&bar[XB_TOPGEN], 1u);
            else XB_SPIN(xb_ld(&bar[XB_TOPGEN]) == tg, bar);
            __builtin_amdgcn_fence(__ATOMIC_ACQUIRE, "agent");
            xb_add(&bar[XB_XGEN(b.x)], 1u);
            asm volatile("s_waitcnt vmcnt(0)" ::: "memory");
        } else {
            XB_SPIN(xb_ld(&bar[XB_XGEN(b.x)]) == gen, bar);
            __builtin_amdgcn_fence(__ATOMIC_ACQUIRE, "agent");
            asm volatile("s_waitcnt vmcnt(0)" ::: "memory");
        }
    }
    __syncthreads();
}

constexpr int NPHASES = 14;


__global__ __launch_bounds__(512, 2) void mk_fwd(Params p) {
    extern __shared__ __attribute__((aligned(16))) unsigned char smem[];
    PG8_LAS unsigned char* lds = (PG8_LAS unsigned char*)smem;
    const int lo = p.ph_lo, hi = p.ph_hi;
    const int G = (int)gridDim.x, c = (int)blockIdx.x;
    const float* mod = (const float*)(p.ws + OFF_MOD);
#define IN(k) (lo <= (k) && (k) < hi)
    volatile PG8_LAS unsigned* xst = (volatile PG8_LAS unsigned*)(lds + 157696);
    if (threadIdx.x == 0) { xst[0] = 0u; xst[1] = 0u; }
    __syncthreads();
    const XcdBarrier xb = xcd_barrier_post((unsigned*)(p.ws + OFF_BAR), xst);
#define SEAM(k) do { if (IN(k) && IN((k) + 1)) xcd_barrier(xb); } while (0)

    if (IN(0)) { phase_prologue(p, smem); } SEAM(0);
    if (IN(1)) {
        {
            pg8::Gemm g{(const bf16_t*)(p.ws + OFF_WPO), (const bf16_t*)(p.ws + OFF_WPW), DM, 512, 512, 2, nullptr, nullptr};
            pg8::Order S; S.init(DM / 256, DM / 256, G, c);
            EpiPlain E{(bf16_t*)(p.ws + OFF_WFOLD)};
            pg8::gemm_phase(lds, g, S, E);
        }
        phase_modulate(p.in[0], p.in[2], MTOT, p.in[6], mod, 0, 1, (bf16_t*)((unsigned char*)p.out + OUT_HN));
        {
            const int lane = threadIdx.x & 63, gw = c * 8 + (threadIdx.x >> 6), NGW = G * 8; const bf16_t* WU = (const bf16_t*)(p.ws + OFF_WUP); float* B2 = (float*)(p.ws + OFF_BIAS2);
            for (int n = gw; n < 2 * DFF; n += NGW) { float s0 = 0.f, s1 = 0.f, s2 = 0.f, s3 = 0.f;
#pragma unroll
                for (int j = 0; j < 4; ++j) { const int k = j * 512 + 8 * lane; float w[8], h[8]; unpack8(*(const u32x4*)(WU + (size_t)n * DM + k), w);
                    load8f(mod + 0 * 12288 + 3 * DM + k, h);
#pragma unroll
                    for (int e = 0; e < 8; ++e) s0 += w[e] * h[e];
                    load8f(mod + 1 * 12288 + 3 * DM + k, h);
#pragma unroll
                    for (int e = 0; e < 8; ++e) s1 += w[e] * h[e];
                    load8f(mod + 2 * 12288 + 3 * DM + k, h);
#pragma unroll
                    for (int e = 0; e < 8; ++e) s2 += w[e] * h[e];
                    load8f(mod + 3 * 12288 + 3 * DM + k, h);
#pragma unroll
                    for (int e = 0; e < 8; ++e) s3 += w[e] * h[e]; }
                s0 = wave_sum(s0); s1 = wave_sum(s1); s2 = wave_sum(s2); s3 = wave_sum(s3);
                if (lane == 0) { B2[n] = s0; B2[2 * DFF + n] = s1; B2[4 * DFF + n] = s2; B2[6 * DFF + n] = s3; } }
        }
    } SEAM(1);
    if (IN(2)) {
        pg8::Gemm g{(const bf16_t*)((unsigned char*)p.out + OUT_HN), (const bf16_t*)((unsigned char*)p.out + OUT_WINT), DM, DM, DM, 0, nullptr, nullptr};
        pg8::Order S; S.init(MLAT / 256, NINP / 256, G, c); S.xM0 = MLAT / 256; S.xnM = MCTX / 256; S.xn = 13; S.xlast = 48;
        EpiProj E{(bf16_t*)(p.ws + OFF_XBC), (bf16_t*)(p.ws + OFF_Z), (float*)(p.ws + OFF_DT), p.in[10]};
        pg8::gemm_phase(lds, g, S, E);
        { const int total = (MLAT / 256) * (NINP / 256) + (MCTX / 256) * 13, rem = total % G;
          if (rem == 0) phase_late_weights(p, smem, c, G); else if (c >= rem) phase_late_weights(p, smem, c - rem, G - rem); }
    } SEAM(2);
    if (IN(3)) { phase_conv_pool(p, smem); }
    SEAM(4);
    if (IN(5)) { phase_ssd_mfma(p, smem); } SEAM(5);
    if (IN(6)) { phase_gate_norm(p); } SEAM(6);
    if (IN(7)) {
        pg8::Order S; S.init(MLAT / 256, DM / 256, G, c); S.dual = 1;
        pg8::Gemm g{(const bf16_t*)(p.ws + OFF_YS), (const bf16_t*)(p.ws + OFF_WSSD), DM, DM, DM, 0, (const bf16_t*)(p.ws + OFF_P), (const bf16_t*)(p.ws + OFF_WFOLD)};
        EpiGateDual E{(bf16_t*)(p.ws + OFF_MG), (const bf16_t*)(p.ws + OFF_GS), (const bf16_t*)(p.ws + OFF_GP)};
        pg8::gemm_phase(lds, g, S, E);
    } SEAM(7);
    if (IN(8)) {
        pg8::Gemm g{(const bf16_t*)(p.ws + OFF_MG), (const bf16_t*)(p.ws + OFF_WO), DM, DM, DM, 0, nullptr, nullptr};
        pg8::Order S; S.init(MLAT / 256, DM / 256, G, c);
        EpiRes1 E{(unsigned short*)p.out, p.in[0], mod, p.in[19], (bf16_t*)(p.ws + OFF_H2), (float*)(p.ws + OFF_ROWSS)};
        pg8::gemm_phase(lds, g, S, E);
    }
    SEAM(9);
    if (IN(10)) {
        pg8::Gemm g{(const bf16_t*)(p.ws + OFF_H2), (const bf16_t*)(p.ws + OFF_WUP), DM, DM, DM, 0, nullptr, nullptr};
        pg8::Order S; S.init(MLAT / 256, 2 * DFF / 256, G, c);
        EpiUp E{(bf16_t*)(p.ws + OFF_UPA), (bf16_t*)(p.ws + OFF_UPG), (const float*)(p.ws + OFF_ROWSS), (const float*)(p.ws + OFF_BIAS2)};
        pg8::gemm_phase(lds, g, S, E);
    } SEAM(10);
    if (IN(11)) { phase_ffn_act(p); } SEAM(11);
    if (IN(12)) {
        pg8::Gemm g{(const bf16_t*)(p.ws + OFF_UPA), (const bf16_t*)(p.ws + OFF_WDN), DFF, DFF, DFF, 0, nullptr, nullptr};
        pg8::Order S; S.init(MLAT / 256, DM / 256, G, c);
        EpiRes E{(unsigned short*)(p.ws + OFF_UPG), (const unsigned short*)p.out, mod + 5 * DM};
        pg8::gemm_phase(lds, g, S, E);
    } SEAM(12);
    if (IN(13)) { phase_final_norm(p); }
    if (hi > NPHASES + 1000) cg::this_grid().sync();
#undef IN
#undef SEAM
}

extern "C" void kernel_launch(void* const* d_in, const int* in_sizes, int n_in, void* d_out, int out_size, void* d_ws, size_t ws_size, hipStream_t stream) {
    static int grid = 0;
    if (grid == 0) {
        if (n_in != 25 || out_size != MLAT * DM || ws_size < WS_END) { fprintf(stderr, "kernel_launch: unexpected shapes (n_in %d out %d ws %zu need %zu)\n", n_in, out_size, ws_size, (size_t)WS_END); grid = -1; return; }
        int dev = 0, cus = 0, per_cu = 0;
        (void)hipGetDevice(&dev); (void)hipDeviceGetAttribute(&cus, hipDeviceAttributeMultiprocessorCount, dev);
        if (hipFuncSetAttribute((const void*)mk_fwd, hipFuncAttributeMaxDynamicSharedMemorySize, LDS_BYTES) != hipSuccess) { fprintf(stderr, "kernel_launch: hipFuncSetAttribute failed\n"); grid = -1; return; }
        if (hipOccupancyMaxActiveBlocksPerMultiprocessor(&per_cu, (const void*)mk_fwd, 512, LDS_BYTES) != hipSuccess || per_cu < 1) per_cu = 1;
        (void)hipGetLastError();
        grid = cus * per_cu;
        if (grid <= 0) grid = 256;
    }
    if (grid < 0) return;
    (void)hipMemsetAsync((unsigned char*)d_ws + OFF_MOD, 0, OFF_DT, stream);
    Params p{};
    for (int i = 0; i < 25; ++i) p.in[i] = (const float*)d_in[i];
    p.out = (float*)d_out; p.ws = (unsigned char*)d_ws;
#if MK_MULTI
    for (int ph = 0; ph < NPHASES; ++ph) { p.ph_lo = ph; p.ph_hi = ph + 1; hipLaunchKernelGGL(mk_fwd, dim3(grid), dim3(512), LDS_BYTES, stream, p); }
#else
    p.ph_lo = 0; p.ph_hi = NPHASES;
    void* args[] = {&p};
    hipError_t e = hipLaunchCooperativeKernel((const void*)mk_fwd, dim3(grid), dim3(512), args, LDS_BYTES, stream);
    if (e != hipSuccess) fprintf(stderr, "cooperative launch failed: %s (grid %d)\n", hipGetErrorString(e), grid);
#ifdef PROBE_EXTRA
    { const int extra[] = PROBE_EXTRA; for (int ph : extra) { p.ph_lo = ph; p.ph_hi = ph + 1; hipLaunchKernelGGL(mk_fwd, dim3(grid), dim3(512), LDS_BYTES, stream, p); } }
#endif
#endif
}
```

```cpp
#include <hip/hip_runtime.h>
#include <hip/hip_cooperative_groups.h>
#include <cstdio>
#include <cstdint>
namespace cg = cooperative_groups;

#ifndef MK_MULTI
#define MK_MULTI 0
#endif

namespace pg8 {
#define PG8_LAS __attribute__((address_space(3)))
typedef unsigned short bf16_t;
typedef short bf16x8 __attribute__((ext_vector_type(8)));
typedef float f32x4 __attribute__((ext_vector_type(4)));
typedef unsigned u32x4 __attribute__((ext_vector_type(4)));
constexpr int BM = 256, BK = 64, HALF = 128, HTB = HALF * BK * 2, STAGE_BYTES = 8 * HTB, NXCD = 8, WGM = 2;

__host__ __device__ __forceinline__ int lds_byte(int r, int c) { const int st = (r >> 4) * 2 + (c >> 5), rr = r & 15, cc = c & 31, ob = rr * 64 + cc * 2; return st * 1024 + (ob ^ (((ob >> 9) & 1) << 5)); }
__host__ __device__ __forceinline__ void stage_rc(int b, int& R, int& C) { const int st = b / 1024, sb = b % 1024, swz = sb ^ (((sb >> 9) & 1) << 5); R = (st >> 1) * 16 + swz / 64; C = (st & 1) * 32 + (swz % 64) / 2; }
__host__ __device__ __forceinline__ int perm32(int rho) { const int n = rho >> 4, i = rho & 15; return 8 * (i >> 2) + 4 * n + (i & 3); }

struct Unit { int pm, pn, half; };
struct Gemm { const bf16_t* A; const bf16_t* Bt; int lda, ldb, K, agrp; const bf16_t* A2; const bf16_t* Bt2; };

struct Order {
    int nM, nN, nwg, G, c, xM0, xnM, xn, xlast, dual;
    __device__ void init(int nM_, int nN_, int G_, int c_) { nM = nM_; nN = nN_; nwg = nM * nN; G = G_; c = c_; xM0 = 0; xnM = 0; xn = 0; xlast = 0; dual = 0; }
    __device__ bool next(int i_, Unit& u) const {
        const int i = dual ? (i_ >> 1) : i_; u.half = dual ? (i_ & 1) : 0;
        const long L = (long)i * G + c;
        if (L >= nwg) { const int e = (int)(L - nwg); if (e >= xnM * xn) return false; const int j = e / xnM; u.pm = xM0 + e % xnM; u.pn = (j < xn - 1) ? j : xlast; return true; }
        int wgid = (int)L; { const int q = nwg / NXCD, r = nwg % NXCD, xcd = wgid % NXCD, off = wgid / NXCD; wgid = (xcd < r ? xcd * (q + 1) : r * (q + 1) + (xcd - r) * q) + off; }
        const int nig = WGM * nN, gid = wgid / nig, fm = gid * WGM, gsz = (nM - fm) < WGM ? (nM - fm) : WGM;
        u.pm = fm + ((wgid % nig) % gsz); u.pn = (wgid % nig) / gsz; return true;
    }
};

__device__ __forceinline__ unsigned cvt_pk_bf16(float lo, float hi) { unsigned r; asm volatile("v_cvt_pk_bf16_f32 %0, %1, %2" : "=v"(r) : "v"(lo), "v"(hi)); return r; }

template <class Epi, class Sched>
__device__ __forceinline__ void gemm_phase(PG8_LAS unsigned char* lds, const Gemm g, const Sched& S, const Epi& E) {
    const int tid = threadIdx.x, wid = __builtin_amdgcn_readfirstlane(tid >> 6), lane = tid & 63, wr = wid >> 2, wc = wid & 3, fr = lane & 15, fq = lane >> 4;
    const int K = g.K, nt = K / BK;
    unsigned voffA[2], voffB[2];
#pragma unroll
    for (int i = 0; i < 2; ++i) { int R, C; stage_rc(tid * 16 + i * 8192, R, C); const int Rb = (R & ~31) + perm32(R & 31);
        voffA[i] = (unsigned)(R * g.lda + C) * 2u; voffB[i] = (unsigned)(Rb * g.ldb + C) * 2u; }
    const size_t kstep = (size_t)(BK * 2);
    const size_t hstepA = (size_t)HALF * g.lda * 2, hstepB = (size_t)HALF * g.ldb * 2;
    const size_t tstepA = 2 * hstepA, tstepB = 2 * hstepB;
    const unsigned ldsw = (unsigned)wid * 1024u;
    const int aoff = lds_byte(wr * 64 + fr, fq * 8), boff = lds_byte(wc * 32 + fr, fq * 8);
#define PG8_SA(b, h) (((b) * 2 + (h)) * HTB)
#define PG8_SB(b, h) ((4 + (b) * 2 + (h)) * HTB)
#define PG8_STAGE(bufoff, gbase, voff) do { _Pragma("unroll") for (int _i = 0; _i < 2; ++_i) \
        __builtin_amdgcn_global_load_lds((const unsigned*)((const char*)(gbase) + (voff)[_i]), (PG8_LAS unsigned*)(lds + (bufoff) + ldsw + _i * 8192), 16, 0, 0); } while (0)
#define PG8_LDA(dst, b, h) do { _Pragma("unroll") for (int m = 0; m < 4; ++m) _Pragma("unroll") for (int k = 0; k < 2; ++k) dst[m][k] = *(const PG8_LAS bf16x8*)(lds + PG8_SA(b, h) + aoff + m * 2048 + k * 1024); } while (0)
#define PG8_LDB(dst, b, h) do { _Pragma("unroll") for (int n = 0; n < 2; ++n) _Pragma("unroll") for (int k = 0; k < 2; ++k) dst[n][k] = *(const PG8_LAS bf16x8*)(lds + PG8_SB(b, h) + boff + n * 2048 + k * 1024); } while (0)
#define PG8_MMA(ai, bj, At, Bt) do { __builtin_amdgcn_s_setprio(1); _Pragma("unroll") for (int m = 0; m < 4; ++m) _Pragma("unroll") for (int n = 0; n < 2; ++n) _Pragma("unroll") for (int k = 0; k < 2; ++k) \
        acc[ai][bj][m][n] = __builtin_amdgcn_mfma_f32_16x16x32_bf16(Bt[n][k], At[m][k], acc[ai][bj][m][n], 0, 0, 0); __builtin_amdgcn_s_setprio(0); } while (0)
#define PG8_WAIT_V(n) asm volatile("s_waitcnt vmcnt(" #n ")" ::: "memory")
#define PG8_WAIT_L(n) asm volatile("s_waitcnt lgkmcnt(" #n ")" ::: "memory")
#define PG8_BAR __builtin_amdgcn_s_barrier()
#define PG8_SCHED __builtin_amdgcn_sched_barrier(0)
#define PG8_ABASE(u) ((const char*)((u).half ? g.A2 : g.A) + (size_t)(u).pm * tstepA + (g.agrp ? (size_t)((u).pn / g.agrp) * (size_t)K * 2 : (size_t)0))
#define PG8_BBASE(u) ((const char*)((u).half ? g.Bt2 : g.Bt) + (size_t)(u).pn * tstepB)
    Unit cur, nxt; int ui = 0;
    if (!S.next(0, cur)) return;
    f32x4 acc[2][2][4][2];
#pragma unroll
    for (int a = 0; a < 2; ++a)
#pragma unroll
        for (int b = 0; b < 2; ++b)
#pragma unroll
            for (int m = 0; m < 4; ++m)
#pragma unroll
                for (int n = 0; n < 2; ++n) acc[a][b][m][n] = (f32x4){0.f, 0.f, 0.f, 0.f};
    bf16x8 At[4][2], B0[2][2], B1[2][2];
    const char* cA = PG8_ABASE(cur); const char* cB = PG8_BBASE(cur);
    PG8_STAGE(PG8_SB(0, 0), cB, voffB); PG8_STAGE(PG8_SB(0, 1), cB + hstepB, voffB); PG8_STAGE(PG8_SA(0, 0), cA, voffA); PG8_STAGE(PG8_SA(0, 1), cA + hstepA, voffA);
    if (wr == 1) PG8_BAR;
    PG8_WAIT_V(2); PG8_BAR;
    PG8_STAGE(PG8_SB(1, 0), cB + kstep, voffB); PG8_STAGE(PG8_SA(1, 0), cA + kstep, voffA); PG8_STAGE(PG8_SB(1, 1), cB + hstepB + kstep, voffB);
    PG8_WAIT_V(6); PG8_BAR;
    for (;;) {
        const bool has_next = S.next(ui + 1, nxt);
        const char* nA = has_next ? PG8_ABASE(nxt) : cA; const char* nB = has_next ? PG8_BBASE(nxt) : cB;
        for (int t = 0; t < nt; t += 2) {
            const bool last = (t == nt - 2);
            const char* a1 = cA + (size_t)(t + 1) * kstep;
            const char* a2 = last ? nA : cA + (size_t)(t + 2) * kstep; const char* b2 = last ? nB : cB + (size_t)(t + 2) * kstep;
            const char* a3 = a2 + kstep; const char* b3 = b2 + kstep;
            PG8_LDB(B0, 0, 0); PG8_LDB(B1, 0, 1); PG8_SCHED; PG8_LDA(At, 0, 0); PG8_STAGE(PG8_SA(1, 1), a1 + hstepA, voffA);
            PG8_WAIT_V(8); PG8_WAIT_L(0); PG8_BAR; PG8_MMA(0, 0, At, B0); PG8_MMA(0, 1, At, B1); PG8_BAR; PG8_SCHED;
            PG8_LDA(At, 0, 1); PG8_STAGE(PG8_SB(0, 0), b2, voffB); PG8_STAGE(PG8_SB(0, 1), b2 + hstepB, voffB); PG8_STAGE(PG8_SA(0, 0), a2, voffA);
            PG8_WAIT_V(8); PG8_WAIT_L(0); PG8_BAR; PG8_MMA(1, 0, At, B0); PG8_MMA(1, 1, At, B1); PG8_BAR; PG8_SCHED;
            PG8_LDB(B0, 1, 0); PG8_LDB(B1, 1, 1); PG8_SCHED; PG8_LDA(At, 1, 0); PG8_STAGE(PG8_SA(0, 1), a2 + hstepA, voffA);
            PG8_WAIT_V(8); PG8_WAIT_L(0); PG8_BAR; PG8_MMA(0, 0, At, B0); PG8_MMA(0, 1, At, B1); PG8_BAR; PG8_SCHED;
            PG8_LDA(At, 1, 1); PG8_STAGE(PG8_SB(1, 0), b3, voffB); PG8_STAGE(PG8_SB(1, 1), b3 + hstepB, voffB); PG8_STAGE(PG8_SA(1, 0), a3, voffA);
            PG8_WAIT_V(8); PG8_WAIT_L(0); PG8_BAR; PG8_MMA(1, 0, At, B0); PG8_MMA(1, 1, At, B1); PG8_BAR; PG8_SCHED;
        }
        if (wr == 0) PG8_BAR;
        asm volatile("s_nop 15\n\ts_nop 7" ::: "memory");
        const bool keep = E(acc, cur, wr, wc, fr, fq);
        if (!has_next) break;
        if (!keep)
#pragma unroll
        for (int a = 0; a < 2; ++a)
#pragma unroll
            for (int b = 0; b < 2; ++b)
#pragma unroll
                for (int m = 0; m < 4; ++m)
#pragma unroll
                    for (int n = 0; n < 2; ++n) acc[a][b][m][n] = (f32x4){0.f, 0.f, 0.f, 0.f};
        cur = nxt; cA = nA; cB = nB; ++ui;
        if (wr == 1) PG8_BAR;
    }
    PG8_WAIT_V(0);
    PG8_BAR;
#undef PG8_SA
#undef PG8_SB
#undef PG8_STAGE
#undef PG8_LDA
#undef PG8_LDB
#undef PG8_MMA
#undef PG8_WAIT_V
#undef PG8_WAIT_L
#undef PG8_BAR
#undef PG8_SCHED
#undef PG8_ABASE
#undef PG8_BBASE
}
}

using pg8::bf16_t; using pg8::f32x4; using pg8::u32x4; using pg8::Unit;
typedef unsigned u32x2 __attribute__((ext_vector_type(2)));

constexpr int DM = 2048, NBATCH = 4, SEQ = 4096, MLAT = NBATCH * SEQ, CTXL = 256, MCTX = NBATCH * CTXL, MTOT = MLAT + MCTX;
constexpr int DFF = 5632, NIN = 12352, NINP = 12544, NXBC = 4096;
constexpr float EPS = 1e-6f;
constexpr int LDS_BYTES = 157696 + 16;

constexpr size_t OFF_MOD = 0;
constexpr size_t OFF_BAR = 245760;
constexpr size_t OFF_ROWSS = 262144;
constexpr size_t OFF_DT = 327680;
constexpr size_t OFF_XC = OFF_DT + (size_t)MTOT * 64 * 4;
constexpr size_t OFF_WUP = OFF_XC + (size_t)MCTX * 4096 * 2;
constexpr size_t OFF_WDN = OFF_WUP + (size_t)2 * DFF * DM * 2;
constexpr size_t OFF_WSSD = OFF_WDN + (size_t)DM * DFF * 2;
constexpr size_t OFF_WPO = OFF_WSSD + (size_t)DM * DM * 2;
constexpr size_t OFF_WO = OFF_WPO + (size_t)DM * DM * 2;
constexpr size_t OFF_WPW = OFF_WO + (size_t)DM * DM * 2;
constexpr size_t OFF_XBC = OFF_WPW + (size_t)2048 * 512 * 2;
constexpr size_t SZ_ACT = (size_t)MLAT * DM * 2;
constexpr size_t OFF_Z = OFF_XBC + (size_t)MTOT * 4096 * 2;
constexpr size_t OFF_V = OFF_Z + SZ_ACT;
constexpr size_t OFF_GS = OFF_V + SZ_ACT;
constexpr size_t OFF_GP = OFF_GS + SZ_ACT;
constexpr size_t OFF_WFOLD = OFF_GP + SZ_ACT;
constexpr size_t OFF_BIAS2 = OFF_WFOLD + (size_t)DM * DM * 2;
constexpr size_t WS_END = OFF_BIAS2 + (size_t)4 * 2 * DFF * 4;
constexpr size_t OFF_P = OFF_V;
constexpr size_t OFF_YF = OFF_XBC + SZ_ACT, OFF_YB = OFF_XBC, OFF_YS = OFF_Z, OFF_T1 = OFF_V, OFF_MG = OFF_XBC, OFF_H2 = OFF_GP;
constexpr size_t OFF_UPA = OFF_WSSD;
constexpr size_t OFF_UPG = OFF_UPA + (size_t)MLAT * DFF * 2;
static_assert(OFF_UPG + (size_t)MLAT * DFF * 2 <= OFF_H2, "up buffers overlap h2");
constexpr size_t OUT_HN = 0;
constexpr size_t OUT_WINT = (size_t)MTOT * DM * 2;
static_assert(OUT_WINT + (size_t)NINP * DM * 2 <= (size_t)MLAT * DM * 4, "d_out overlay");

struct Params { const float* in[25]; float* out; unsigned char* ws; int ph_lo, ph_hi; };

__device__ __forceinline__ float bflo(unsigned u) { return __uint_as_float(u << 16); }
__device__ __forceinline__ float bfhi(unsigned u) { return __uint_as_float(u & 0xffff0000u); }
__device__ __forceinline__ unsigned pk2(float lo, float hi) { return pg8::cvt_pk_bf16(lo, hi); }
__device__ __forceinline__ void unpack8(const u32x4 r, float (&o)[8]) { o[0] = bflo(r.x); o[1] = bfhi(r.x); o[2] = bflo(r.y); o[3] = bfhi(r.y); o[4] = bflo(r.z); o[5] = bfhi(r.z); o[6] = bflo(r.w); o[7] = bfhi(r.w); }
__device__ __forceinline__ u32x4 pack8(const float (&o)[8]) { u32x4 r; r.x = pk2(o[0], o[1]); r.y = pk2(o[2], o[3]); r.z = pk2(o[4], o[5]); r.w = pk2(o[6], o[7]); return r; }
typedef _Float16 h16x2 __attribute__((ext_vector_type(2)));
__device__ __forceinline__ unsigned pkh2(float lo, float hi) { h16x2 v; v.x = (_Float16)lo; v.y = (_Float16)hi; return __builtin_bit_cast(unsigned, v); }
__device__ __forceinline__ u32x4 packh44(const f32x4 a, const f32x4 b) { u32x4 w; w.x = pkh2(a[0], a[1]); w.y = pkh2(a[2], a[3]); w.z = pkh2(b[0], b[1]); w.w = pkh2(b[2], b[3]); return w; }
__device__ __forceinline__ void unpackh44(const u32x4 r, f32x4& a, f32x4& b) {
    const unsigned r0 = r.x, r1 = r.y, r2 = r.z, r3 = r.w;
    const h16x2 p0 = __builtin_bit_cast(h16x2, r0), p1 = __builtin_bit_cast(h16x2, r1), p2 = __builtin_bit_cast(h16x2, r2), p3 = __builtin_bit_cast(h16x2, r3);
    a = (f32x4){(float)p0.x, (float)p0.y, (float)p1.x, (float)p1.y}; b = (f32x4){(float)p2.x, (float)p2.y, (float)p3.x, (float)p3.y}; }
__device__ __forceinline__ float wave_sum(float v) {
#pragma unroll
    for (int o = 1; o < 64; o <<= 1) v += __shfl_xor(v, o);
    return v;
}
__device__ __forceinline__ float wave_incl_scan(float x) {
#define DPP_ADD(ctrl_, rmask_) x += __int_as_float(__builtin_amdgcn_update_dpp(0, __float_as_int(x), ctrl_, rmask_, 0xf, false))
    DPP_ADD(0x111, 0xf); DPP_ADD(0x112, 0xf); DPP_ADD(0x114, 0xf); DPP_ADD(0x118, 0xf); DPP_ADD(0x142, 0xa); DPP_ADD(0x143, 0xc);
#undef DPP_ADD
    return x;
}
__device__ __forceinline__ float sigmoidf_(float x) { return __builtin_amdgcn_rcpf(1.0f + __expf(-x)); }
__device__ __forceinline__ float siluf_(float x) { return x * __builtin_amdgcn_rcpf(1.0f + __expf(-x)); }
typedef float f32x2 __attribute__((ext_vector_type(2)));
__device__ __forceinline__ f32x2 gelu_pk(f32x2 v) {
    const f32x2 av = __builtin_elementwise_abs(v), d = av * 0.2316418882f + 1.0f;
    f32x2 t; t.x = __builtin_amdgcn_rcpf(d.x); t.y = __builtin_amdgcn_rcpf(d.y);
    f32x2 q = t * 0.5307027145f + (-0.7265760135f); q = q * t + 0.7107068705f; q = q * t + (-0.142248368f); q = q * t + 0.127414796f; q = q * t;
    const f32x2 s = (v * v) * (-0.72134752044f);
    f32x2 e; e.x = __builtin_amdgcn_exp2f(s.x); e.y = __builtin_amdgcn_exp2f(s.y);
    const f32x2 m = v * (q * e), r = v - m;
    f32x2 o; o.x = v.x < 0.f ? m.x : r.x; o.y = v.y < 0.f ? m.y : r.y; return o;
}
__device__ __forceinline__ float softplusf_(float x) { return fmaxf(x, 0.f) + log1pf(__expf(-fabsf(x))); }
__device__ __forceinline__ void load8f(const float* p, float (&o)[8]) { const f32x4 a = *(const f32x4*)p, b = *(const f32x4*)(p + 4); o[0] = a.x; o[1] = a.y; o[2] = a.z; o[3] = a.w; o[4] = b.x; o[5] = b.y; o[6] = b.z; o[7] = b.w; }

#define EPI_LOOP_BEGIN \
    const int row0 = u.pm * 256 + wr * 64 + fr, cl0 = wc * 32 + 8 * fq; \
    _Pragma("unroll") for (int ai = 0; ai < 2; ++ai) _Pragma("unroll") for (int m = 0; m < 4; ++m) { const int row = row0 + ai * 128 + m * 16; \
    _Pragma("unroll") for (int bj = 0; bj < 2; ++bj) { const int cl = cl0 + bj * 128; const f32x4 v0 = acc[ai][bj][m][0], v1 = acc[ai][bj][m][1];
#define EPI_LOOP_END } }
__device__ __forceinline__ u32x4 pack44(const f32x4 a, const f32x4 b) { u32x4 w; w.x = pk2(a[0], a[1]); w.y = pk2(a[2], a[3]); w.z = pk2(b[0], b[1]); w.w = pk2(b[2], b[3]); return w; }

struct EpiProj {
    bf16_t* xbc; bf16_t* zvg; float* dt; const float* dt_bias;
    __device__ __forceinline__ bool operator()(f32x4 (&acc)[2][2][4][2], const Unit& u, int wr, int wc, int fr, int fq) const {
        if (u.pn < 16) {
            EPI_LOOP_BEGIN *(u32x4*)(xbc + (size_t)row * 4096 + u.pn * 256 + cl) = pack44(v0, v1); EPI_LOOP_END
        } else if (u.pn < 48) {
            bf16_t* base = zvg + (size_t)((u.pn - 16) >> 3) * ((size_t)MLAT * DM) + ((u.pn - 16) & 7) * 256;
            EPI_LOOP_BEGIN *(u32x4*)(base + (size_t)row * DM + cl) = pack44(v0, v1); EPI_LOOP_END
        } else {
            EPI_LOOP_BEGIN
                if (cl < 64) { const f32x4 b0 = *(const f32x4*)(dt_bias + cl), b1 = *(const f32x4*)(dt_bias + cl + 4); f32x4 o0, o1;
#pragma unroll
                    for (int e = 0; e < 4; ++e) { o0[e] = softplusf_(v0[e] + b0[e]); o1[e] = softplusf_(v1[e] + b1[e]); }
                    *(f32x4*)(dt + (size_t)row * 64 + cl) = o0; *(f32x4*)(dt + (size_t)row * 64 + cl + 4) = o1; }
            EPI_LOOP_END
        }
        return false;
    }
};
struct EpiPlain {
    bf16_t* o;
    __device__ __forceinline__ bool operator()(f32x4 (&acc)[2][2][4][2], const Unit& u, int wr, int wc, int fr, int fq) const {
        EPI_LOOP_BEGIN *(u32x4*)(o + (size_t)row * DM + u.pn * 256 + cl) = pack44(v0, v1); EPI_LOOP_END
        return false;
    }
};
struct EpiScale {
    bf16_t* o; const float* scale;
    __device__ __forceinline__ bool operator()(f32x4 (&acc)[2][2][4][2], const Unit& u, int wr, int wc, int fr, int fq) const {
        EPI_LOOP_BEGIN const int col = u.pn * 256 + cl; const f32x4 s0 = *(const f32x4*)(scale + col), s1 = *(const f32x4*)(scale + col + 4);
            *(u32x4*)(o + (size_t)row * DM + col) = pack44(v0 * s0, v1 * s1); EPI_LOOP_END
        return false;
    }
};
template <int SECOND> struct EpiGate {
    bf16_t* o; const bf16_t* gate; const bf16_t* t1;
    __device__ __forceinline__ bool operator()(f32x4 (&acc)[2][2][4][2], const Unit& u, int wr, int wc, int fr, int fq) const {
        EPI_LOOP_BEGIN const size_t off = (size_t)row * DM + u.pn * 256 + cl; float gt[8]; unpack8(*(const u32x4*)(gate + off), gt);
            float r[8];
#pragma unroll
            for (int e = 0; e < 4; ++e) { r[e] = sigmoidf_(gt[e]) * v0[e]; r[4 + e] = sigmoidf_(gt[4 + e]) * v1[e]; }
            if (SECOND) { float pv[8]; unpack8(*(const u32x4*)(t1 + off), pv);
#pragma unroll
                for (int e = 0; e < 8; ++e) r[e] += pv[e]; }
            *(u32x4*)(o + off) = pack8(r); EPI_LOOP_END
        return false;
    }
};
struct EpiGateDual {
    bf16_t* o; const bf16_t* gs; const bf16_t* gp;
    __device__ __forceinline__ bool operator()(f32x4 (&acc)[2][2][4][2], const Unit& u, int wr, int wc, int fr, int fq) const {
        const int row0 = u.pm * 256 + wr * 64 + fr, cl0 = wc * 32 + 8 * fq;
        if (u.half == 0) {
#pragma unroll
            for (int ai = 0; ai < 2; ++ai)
#pragma unroll
                for (int m = 0; m < 4; ++m)
#pragma unroll
                    for (int bj = 0; bj < 2; ++bj) { const size_t off = (size_t)(row0 + ai * 128 + m * 16) * DM + u.pn * 256 + cl0 + bj * 128;
                        float a[8], b[8]; unpack8(*(const u32x4*)(gs + off), a); unpack8(*(const u32x4*)(gp + off), b);
#pragma unroll
                        for (int e = 0; e < 4; ++e) { acc[ai][bj][m][0][e] *= (1.0f + __expf(-b[e])) * __builtin_amdgcn_rcpf(1.0f + __expf(-a[e]));
                                                      acc[ai][bj][m][1][e] *= (1.0f + __expf(-b[4 + e])) * __builtin_amdgcn_rcpf(1.0f + __expf(-a[4 + e])); } }
            return true;
        }
#pragma unroll
        for (int ai = 0; ai < 2; ++ai)
#pragma unroll
            for (int m = 0; m < 4; ++m)
#pragma unroll
                for (int bj = 0; bj < 2; ++bj) { const size_t off = (size_t)(row0 + ai * 128 + m * 16) * DM + u.pn * 256 + cl0 + bj * 128;
                    float b[8], r[8]; unpack8(*(const u32x4*)(gp + off), b);
#pragma unroll
                    for (int e = 0; e < 4; ++e) { r[e] = acc[ai][bj][m][0][e] * sigmoidf_(b[e]); r[4 + e] = acc[ai][bj][m][1][e] * sigmoidf_(b[4 + e]); }
                    *(u32x4*)(o + off) = pack8(r); }
        return false;
    }
};
struct EpiRes {
    unsigned short* o; const unsigned short* base; const float* gate;
    __device__ __forceinline__ bool operator()(f32x4 (&acc)[2][2][4][2], const Unit& u, int wr, int wc, int fr, int fq) const {
        const float* gp0 = gate + (size_t)((u.pm * 256) >> 12) * 12288 + u.pn * 256 + wc * 32 + 8 * fq;
        const f32x4 ga0 = *(const f32x4*)gp0, ga1 = *(const f32x4*)(gp0 + 4), gb0 = *(const f32x4*)(gp0 + 128), gb1 = *(const f32x4*)(gp0 + 132);
        EPI_LOOP_BEGIN const int col = u.pn * 256 + cl; const size_t off = (size_t)row * DM + col;
            const f32x4 g0 = bj ? gb0 : ga0, g1 = bj ? gb1 : ga1; f32x4 x0, x1; unpackh44(*(const u32x4*)(base + off), x0, x1);
            *(u32x4*)(o + off) = packh44(x0 + g0 * v0, x1 + g1 * v1); EPI_LOOP_END
        return false;
    }
};
struct EpiRes1 {
    unsigned short* o; const float* base; const float* mod; const float* n2w; bf16_t* xm; float* rowss;
    __device__ __forceinline__ bool operator()(f32x4 (&acc)[2][2][4][2], const Unit& u, int wr, int wc, int fr, int fq) const {
        const int row0 = u.pm * 256 + wr * 64 + fr, cl0 = wc * 32 + 8 * fq; const float* mr = mod + (size_t)(row0 >> 12) * 12288;
        f32x4 hg[2][2], hw[2][2];
#pragma unroll
        for (int bj = 0; bj < 2; ++bj) { const int col = u.pn * 256 + cl0 + bj * 128;
            hg[bj][0] = *(const f32x4*)(mr + 2 * DM + col); hg[bj][1] = *(const f32x4*)(mr + 2 * DM + col + 4);
            hw[bj][0] = *(const f32x4*)(n2w + col) * (*(const f32x4*)(mr + 4 * DM + col) + 1.0f); hw[bj][1] = *(const f32x4*)(n2w + col + 4) * (*(const f32x4*)(mr + 4 * DM + col + 4) + 1.0f); }
#pragma unroll
        for (int ai = 0; ai < 2; ++ai)
#pragma unroll
            for (int m = 0; m < 4; ++m) { const int row = row0 + ai * 128 + m * 16; float ss = 0.f;
#pragma unroll
                for (int bj = 0; bj < 2; ++bj) { const int col = u.pn * 256 + cl0 + bj * 128; const size_t off = (size_t)row * DM + col;
                    const f32x4 g0 = hg[bj][0], g1 = hg[bj][1], x0 = *(const f32x4*)(base + off), x1 = *(const f32x4*)(base + off + 4);
                    const f32x4 r0 = x0 + g0 * acc[ai][bj][m][0], r1 = x1 + g1 * acc[ai][bj][m][1];
                    *(u32x4*)(o + off) = packh44(r0, r1);
                    ss += (r0.x * r0.x + r0.y * r0.y) + (r0.z * r0.z + r0.w * r0.w) + (r1.x * r1.x + r1.y * r1.y) + (r1.z * r1.z + r1.w * r1.w);
                    const f32x4 w0 = hw[bj][0], w1 = hw[bj][1];
                    *(u32x4*)(xm + off) = pack44(r0 * w0, r1 * w1); }
                ss += __shfl_xor(ss, 16); ss += __shfl_xor(ss, 32);
                if (fq == 0) atomicAdd(rowss + row, ss); }
        return false;
    }
};
struct EpiUp {
    bf16_t* a; bf16_t* g; const float* rowss; const float* bias2;
    __device__ __forceinline__ bool operator()(f32x4 (&acc)[2][2][4][2], const Unit& u, int wr, int wc, int fr, int fq) const {
        bf16_t* base = (u.pn < 22) ? a + u.pn * 256 : g + (u.pn - 22) * 256;
        const int row0 = u.pm * 256 + wr * 64 + fr, cl0 = wc * 32 + 8 * fq; const float* bb = bias2 + (size_t)(row0 >> 12) * (2 * DFF) + u.pn * 256 + cl0;
        const f32x4 b00 = *(const f32x4*)bb, b01 = *(const f32x4*)(bb + 4), b10 = *(const f32x4*)(bb + 128), b11 = *(const f32x4*)(bb + 132);
#pragma unroll
        for (int ai = 0; ai < 2; ++ai)
#pragma unroll
            for (int m = 0; m < 4; ++m) { const int row = row0 + ai * 128 + m * 16; const float rstd = rsqrtf(rowss[row] * (1.0f / DM) + EPS);
                *(u32x4*)(base + (size_t)row * DFF + cl0) = pack44(acc[ai][0][m][0] * rstd + b00, acc[ai][0][m][1] * rstd + b01);
                *(u32x4*)(base + (size_t)row * DFF + cl0 + 128) = pack44(acc[ai][1][m][0] * rstd + b10, acc[ai][1][m][1] * rstd + b11); }
        return false;
    }
};

#define LDS_WAIT() asm volatile("s_waitcnt lgkmcnt(0)" ::: "memory")

__device__ __forceinline__ void transpose_item(const float* W, int N, int k0, int n0, bf16_t* WT, int ldt, int dst_row0, float* scr, int lane) {
    float tv[32];
#pragma unroll
    for (int i = 0; i < 32; ++i) tv[i] = W[(size_t)(k0 + 2 * i + (lane >> 5)) * N + n0 + (lane & 31)];
#pragma unroll
    for (int i = 0; i < 32; ++i) scr[(2 * i + (lane >> 5)) * 33 + (lane & 31)] = tv[i];
    LDS_WAIT();
    const int c = lane & 7;
#pragma unroll
    for (int j = 0; j < 4; ++j) { const int n = (lane >> 3) + 8 * j; const float* s = scr + (8 * c) * 33 + n;
        u32x4 o; o.x = pk2(s[0 * 33], s[1 * 33]); o.y = pk2(s[2 * 33], s[3 * 33]); o.z = pk2(s[4 * 33], s[5 * 33]); o.w = pk2(s[6 * 33], s[7 * 33]);
        *(u32x4*)(WT + (size_t)(dst_row0 + n) * ldt + k0 + 8 * c) = o; }
    LDS_WAIT();
}

__device__ __forceinline__ void phase_prologue(const Params& p, unsigned char* smem) {
    const int tid = threadIdx.x, lane = tid & 63, wave = tid >> 6;
    const int gtid = blockIdx.x * 512 + tid, NT = gridDim.x * 512;
    float* sc = (float*)smem;
    for (int i = tid; i < 5 * DM; i += 512) { const int r = i >> 11, k = i & 2047; const float v = (r < 4) ? p.in[1][r * DM + k] : p.in[3][k]; sc[i] = v / (1.0f + expf(-v)); }
    __syncthreads();
    float* mod = (float*)(p.ws + OFF_MOD);
    for (int task = gtid; task < 3072 * 42; task += NT) {
        const int cq = task % 3072, ks = task / 3072, k0 = ks * 49, kn = min(49, DM - k0);
        f32x4 a0 = {0.f, 0.f, 0.f, 0.f}, a1 = a0, a2 = a0, a3 = a0, a4 = a0;
        const float* wp = p.in[4] + (size_t)k0 * 12288 + cq * 4;
#pragma unroll 7
        for (int kk = 0; kk < kn; ++kk) { const f32x4 w = *(const f32x4*)(wp + (size_t)kk * 12288); const int k = k0 + kk;
            a0 += sc[k] * w; a1 += sc[DM + k] * w; a2 += sc[2 * DM + k] * w; a3 += sc[3 * DM + k] * w; a4 += sc[4 * DM + k] * w; }
        if (ks == 0) { const f32x4 b = *(const f32x4*)(p.in[5] + cq * 4); a0 += b; a1 += b; a2 += b; a3 += b; a4 += b; }
#pragma unroll
        for (int e = 0; e < 4; ++e) { atomicAdd(mod + 0 * 12288 + cq * 4 + e, a0[e]); atomicAdd(mod + 1 * 12288 + cq * 4 + e, a1[e]); atomicAdd(mod + 2 * 12288 + cq * 4 + e, a2[e]);
            atomicAdd(mod + 3 * 12288 + cq * 4 + e, a3[e]); atomicAdd(mod + 4 * 12288 + cq * 4 + e, a4[e]); }
    }
    __syncthreads();
    float* scr = (float*)smem + wave * (64 * 33);
    bf16_t* WINT = (bf16_t*)((unsigned char*)p.out + OUT_WINT);
    const int gw = blockIdx.x * 8 + wave, NGW = gridDim.x * 8;
    constexpr int I_IN = 32 * (NIN / 32), I_SQ = 32 * 64, I_UP = 32 * (2 * DFF / 32), I_DN = (DFF / 64) * 64;
    constexpr int NITEMS = I_IN + I_SQ + I_UP;
    (void)I_DN;
    for (int it = gw; it < NITEMS; it += NGW) {
        int r = it;
        if (r < I_IN) { const int nblk = NIN / 32, kb = r / nblk, nb = r % nblk, n0 = 32 * nb; const int drow = (n0 >= 64) ? n0 - 64 : 12288 + n0;
            transpose_item(p.in[7], NIN, 64 * kb, n0, WINT, DM, drow, scr, lane); continue; } r -= I_IN;
        if (r < I_SQ) { transpose_item(p.in[17], DM, 64 * (r / 64), 32 * (r % 64), (bf16_t*)(p.ws + OFF_WPO), DM, 32 * (r % 64), scr, lane); continue; } r -= I_SQ;
        { const int nblk = 2 * DFF / 32; transpose_item(p.in[20], 2 * DFF, 64 * (r / nblk), 32 * (r % nblk), (bf16_t*)(p.ws + OFF_WUP), DM, 32 * (r % nblk), scr, lane); }
    }
    for (int i = gtid; i < 2048 * 64; i += NT) { const int row = i >> 6, o8 = (i & 63) * 8; float w[8], s[8], o[8]; load8f(p.in[15] + (size_t)row * 512 + o8, w); load8f(p.in[16] + (row >> 9) * 512 + o8, s);
#pragma unroll
        for (int e = 0; e < 8; ++e) o[e] = w[e] * s[e];
        *(u32x4*)((bf16_t*)(p.ws + OFF_WPW) + (size_t)row * 512 + o8) = pack8(o); }
    { u32x4* z = (u32x4*)(WINT + (size_t)NIN * DM); const u32x4 zero = {0u, 0u, 0u, 0u};
      for (int i = gtid; i < (NINP - NIN) * DM / 8; i += NT) z[i] = zero; }
}

__device__ __forceinline__ void phase_late_weights(const Params& p, unsigned char* smem, int widx, int nw) {
    const int lane = threadIdx.x & 63, wave = threadIdx.x >> 6;
    float* scr = (float*)smem + wave * (64 * 33);
    constexpr int I_SQ = 32 * 64, I_DN = (DFF / 64) * 64;
    for (int it = widx * 8 + wave; it < 2 * I_SQ + I_DN; it += nw * 8) {
        int r = it;
        if (r < I_SQ) { transpose_item(p.in[14], DM, 64 * (r / 64), 32 * (r % 64), (bf16_t*)(p.ws + OFF_WSSD), DM, 32 * (r % 64), scr, lane); continue; } r -= I_SQ;
        if (r < I_SQ) { transpose_item(p.in[18], DM, 64 * (r / 64), 32 * (r % 64), (bf16_t*)(p.ws + OFF_WO), DM, 32 * (r % 64), scr, lane); continue; } r -= I_SQ;
        { transpose_item(p.in[23], DM, 64 * (r / 64), 32 * (r % 64), (bf16_t*)(p.ws + OFF_WDN), DFF, 32 * (r % 64), scr, lane); }
    }
}

__device__ __forceinline__ void phase_modulate(const float* src_lat, const float* src_ctx, int nrows, const float* normw, const float* mod, int shidx, int scidx, bf16_t* dst) {
    const int lane = threadIdx.x & 63, rpb = (nrows + (int)gridDim.x - 1) / (int)gridDim.x, rend = min(nrows, ((int)blockIdx.x + 1) * rpb), gw = blockIdx.x * rpb + (threadIdx.x >> 6), NGW = 8;
    f32x4 v[8], wsc[8], shv[8]; int cur_mi = -1;
    if (gw < rend) { const float* xr = (gw < MLAT) ? src_lat + (size_t)gw * DM : src_ctx + (size_t)(gw - MLAT) * DM;
#pragma unroll
        for (int j = 0; j < 8; ++j) v[j] = *(const f32x4*)(xr + 4 * (lane + 64 * j)); }
    for (int row = gw; row < rend; row += NGW) {
        f32x4 nv[8]; const int nrow = row + NGW;
        if (nrow < rend) { const float* xr = (nrow < MLAT) ? src_lat + (size_t)nrow * DM : src_ctx + (size_t)(nrow - MLAT) * DM;
#pragma unroll
            for (int j = 0; j < 8; ++j) nv[j] = *(const f32x4*)(xr + 4 * (lane + 64 * j)); }
        const int mi = (row < MLAT) ? (row >> 12) : 4;
        if (mi != cur_mi) { cur_mi = mi; const float* mr = mod + (size_t)mi * 12288;
#pragma unroll
            for (int j = 0; j < 8; ++j) { const int col = 4 * (lane + 64 * j); wsc[j] = *(const f32x4*)(normw + col) * (*(const f32x4*)(mr + scidx * DM + col) + 1.0f); shv[j] = *(const f32x4*)(mr + shidx * DM + col); } }
        float s = 0.f;
#pragma unroll
        for (int j = 0; j < 8; ++j) s += (v[j].x * v[j].x + v[j].y * v[j].y) + (v[j].z * v[j].z + v[j].w * v[j].w);
        const float rstd = rsqrtf(wave_sum(s) * (1.0f / DM) + EPS);
#pragma unroll
        for (int j = 0; j < 8; ++j) { const int col = 4 * (lane + 64 * j);
            const f32x4 o = (v[j] * rstd) * wsc[j] + shv[j];
            u32x2 pk; pk.x = pk2(o.x, o.y); pk.y = pk2(o.z, o.w); *(u32x2*)(dst + (size_t)row * DM + col) = pk; }
        if (nrow < rend) {
#pragma unroll
            for (int j = 0; j < 8; ++j) v[j] = nv[j]; }
    }
}

__device__ __forceinline__ void phase_conv_pool(const Params& p, unsigned char* smem) {
    const int tid = threadIdx.x, gtid = blockIdx.x * 512 + tid, NT = gridDim.x * 512;
    const bf16_t* raw = (const bf16_t*)(p.ws + OFF_XBC); const float* cw = p.in[8]; const float* cb = p.in[9];
    bf16_t* xcl = (bf16_t*)p.out; bf16_t* xcc = (bf16_t*)(p.ws + OFF_XC);
    const u32x4 zero = {0u, 0u, 0u, 0u};
    {
        const int col = tid * 8, tpb = (MLAT + (int)gridDim.x - 1) / (int)gridDim.x, t0 = blockIdx.x * tpb, t1 = min(t0 + tpb, MLAT);
        float w0[8], w1[8], w2[8], bb[8]; load8f(cw + col, w0); load8f(cw + 4096 + col, w1); load8f(cw + 8192 + col, w2); load8f(cb + col, bb);
        if (t0 < t1) {
            const bf16_t* src = raw + (size_t)t0 * 4096 + col; bf16_t* dst = xcl + (size_t)t0 * 4096 + col;
            float x0[8], x1[8];
            unpack8(((t0 & (SEQ - 1)) != 0) ? *(const u32x4*)(src - 4096) : zero, x0); unpack8(*(const u32x4*)src, x1);
#pragma unroll 4
            for (int t = t0; t < t1; ++t) {
                const u32x4 r2 = (((t + 1) & (SEQ - 1)) != 0) ? __builtin_nontemporal_load((const u32x4*)(src + 4096)) : zero;
                float x2[8], o[8]; unpack8(r2, x2);
#pragma unroll
                for (int e = 0; e < 8; ++e) o[e] = siluf_(x0[e] * w0[e] + bb[e] + x1[e] * w1[e] + x2[e] * w2[e]);
                *(u32x4*)dst = pack8(o);
#pragma unroll
                for (int e = 0; e < 8; ++e) { x0[e] = x1[e]; x1[e] = x2[e]; }
                src += 4096; dst += 4096;
            }
        }
    }
    for (int idx = gtid; idx < MCTX * 384; idx += NT) {
        const int t = idx / 384, col = (idx % 384) * 8, tl = t & (CTXL - 1); const bf16_t* src = raw + (size_t)(MLAT + t) * 4096 + col; bf16_t* dst = xcc + (size_t)t * 4096 + col;
        const u32x4 r1 = *(const u32x4*)src; const u32x4 r0 = (tl > 0) ? *(const u32x4*)(src - 4096) : zero; const u32x4 r2 = (tl < CTXL - 1) ? *(const u32x4*)(src + 4096) : zero;
        float x0[8], x1[8], x2[8], w0[8], w1[8], w2[8], b[8], o[8];
        unpack8(r0, x0); unpack8(r1, x1); unpack8(r2, x2); load8f(cw + col, w0); load8f(cw + 4096 + col, w1); load8f(cw + 8192 + col, w2); load8f(cb + col, b);
#pragma unroll
        for (int e = 0; e < 8; ++e) o[e] = siluf_(x0[e] * w0[e] + b[e] + x1[e] * w1[e] + x2[e] * w2[e]);
        *(u32x4*)dst = pack8(o);
    }
    const bf16_t* V = (const bf16_t*)(p.ws + OFF_V); bf16_t* P = (bf16_t*)(p.ws + OFF_P);
    PG8_LAS unsigned char* L = (PG8_LAS unsigned char*)smem;
    for (int it = blockIdx.x; it < (MLAT / 64) * 4; it += gridDim.x) {
        const int gr = it >> 2, g = it & 3, hw = 1 << g;
        const bf16_t* base = V + (size_t)gr * 64 * DM + g * 512;
        __syncthreads();
#pragma unroll
        for (int j = 0; j < 8; ++j) { const int piece = tid + 512 * j, row = piece >> 6, pc = piece & 63; *(PG8_LAS u32x4*)(L + row * 1024 + pc * 16) = *(const u32x4*)(base + (size_t)row * DM + pc * 8); }
        __syncthreads();
        const int cvv = tid & 63, tq = tid >> 6;
        float s[8];
#pragma unroll
        for (int e = 0; e < 8; ++e) s[e] = 0.f;
        for (int jj = max(tq * 8 - hw, 0); jj < min(tq * 8 + hw, 64); ++jj) { float x[8]; unpack8(*(const PG8_LAS u32x4*)(L + jj * 1024 + cvv * 16), x);
#pragma unroll
            for (int e = 0; e < 8; ++e) s[e] += x[e]; }
        for (int i = 0; i < 8; ++i) { const int tc = tq * 8 + i, lo = max(tc - hw, 0), hi = min(tc + hw, 64);
            float me[8], o[8];
            if (i > 0) {
                const int ad = tc - 1 + hw, sb = tc - 1 - hw;
                if (ad < 64) { float x[8]; unpack8(*(const PG8_LAS u32x4*)(L + ad * 1024 + cvv * 16), x);
#pragma unroll
                    for (int e = 0; e < 8; ++e) s[e] += x[e]; }
                if (sb >= 0) { float x[8]; unpack8(*(const PG8_LAS u32x4*)(L + sb * 1024 + cvv * 16), x);
#pragma unroll
                    for (int e = 0; e < 8; ++e) s[e] -= x[e]; }
            }
            unpack8(*(const PG8_LAS u32x4*)(L + tc * 1024 + cvv * 16), me);
            const float inv = 1.0f / (float)(hi - lo);
#pragma unroll
            for (int e = 0; e < 8; ++e) o[e] = s[e] * inv - me[e];
            *(u32x4*)(P + (size_t)(gr * 64 + tc) * DM + g * 512 + cvv * 8) = pack8(o); }
    }
}

__device__ __forceinline__ void phase_ssd_scan(const Params& p, unsigned char* smem) {
    const int tid = threadIdx.x, lane = tid & 63, wave = tid >> 6;
    float* sX = (float*)smem;
    float* sB = sX + 32 * 64;
    float* sC = sB + 32 * 128;
    float* sY = sC + 32 * 128;
    float* sdt = sY + 8 * 32 * 64;
    const bf16_t* xcl = (const bf16_t*)p.out; const bf16_t* xcc = (const bf16_t*)(p.ws + OFF_XC); const float* DT = (const float*)(p.ws + OFF_DT);
    for (int item = blockIdx.x; item < 256; item += gridDim.x) {
        const int xcd = item & 7, slot = item >> 3, gid = xcd * 4 + (slot >> 3), mem = slot & 7;
        const int b = gid >> 3, g = gid & 7, dir = mem >> 2, h = g * 4 + (mem & 3);
        const float Ah = -expf(p.in[11][dir * 32 + h]), dsk = p.in[12][dir * 32 + h];
        bf16_t* Y = (bf16_t*)(p.ws + (dir ? OFF_YB : OFF_YF));
        float hs[16];
#pragma unroll
        for (int j = 0; j < 16; ++j) hs[j] = 0.f;
        for (int ck = 0; ck < (CTXL + SEQ) / 32; ++ck) {
            const bool isctx = ck < CTXL / 32;
            __syncthreads();
            {   const int i = tid >> 4, q = tid & 15;
                const int s = ck * 32 + i;
                int tok; const bf16_t* rowp; size_t drow;
                if (isctx) { tok = dir ? (CTXL - 1 - s) : s; rowp = xcc + (size_t)(b * CTXL + tok) * 4096; drow = (size_t)(MLAT + b * CTXL + tok); }
                else { const int s2 = s - CTXL; tok = dir ? (SEQ - 1 - s2) : s2; rowp = xcl + (size_t)(b * SEQ + tok) * 4096; drow = (size_t)(b * SEQ + tok); }
                { const u32x2 xv = *(const u32x2*)(rowp + h * 64 + q * 4); float* d = sX + i * 64 + q * 4; d[0] = bflo(xv.x); d[1] = bfhi(xv.x); d[2] = bflo(xv.y); d[3] = bfhi(xv.y); }
                { float o[8]; unpack8(*(const u32x4*)(rowp + 2048 + g * 128 + q * 8), o); float* d = sB + i * 128 + q * 8;
#pragma unroll
                  for (int e = 0; e < 8; ++e) d[e] = o[e]; }
                if (!isctx) { float o[8]; unpack8(*(const u32x4*)(rowp + 3072 + g * 128 + q * 8), o); float* d = sC + i * 128 + q * 8;
#pragma unroll
                  for (int e = 0; e < 8; ++e) d[e] = o[e]; }
                if (q == 0) { const float dt = DT[drow * 64 + dir * 32 + h]; sdt[i] = dt; sdt[32 + i] = expf(dt * Ah); }
            }
            __syncthreads();
            for (int i = 0; i < 32; ++i) {
                const float dt = sdt[i], dA = sdt[32 + i], xd = sX[i * 64 + lane] * dt;
                const float* bp = sB + i * 128 + wave * 16; const float* cp = sC + i * 128 + wave * 16;
                float yp = 0.f;
#pragma unroll
                for (int j = 0; j < 16; ++j) { hs[j] = hs[j] * dA + xd * bp[j]; yp += cp[j] * hs[j]; }
                sY[(wave * 32 + i) * 64 + lane] = yp;
            }
            __syncthreads();
            if (!isctx) {
                const int i = tid >> 4, q = tid & 15, s2 = ck * 32 + i - CTXL, tok = dir ? (SEQ - 1 - s2) : s2;
                float o[4];
#pragma unroll
                for (int e = 0; e < 4; ++e) { const int pp = q * 4 + e; float a = dsk * sX[i * 64 + pp];
#pragma unroll
                    for (int w = 0; w < 8; ++w) a += sY[(w * 32 + i) * 64 + pp];
                    o[e] = a; }
                u32x2 pk; pk.x = pk2(o[0], o[1]); pk.y = pk2(o[2], o[3]);
                *(u32x2*)(Y + (size_t)(b * SEQ + tok) * DM + h * 64 + q * 4) = pk;
            }
        }
    }
}


constexpr int SS_LD = 272;
constexpr int SS_C = 0, SS_B = 34816, SS_BT = 69632, SS_XT = 104448, SS_HB = 121856, SS_CS = 139264, SS_DT = 139776, SS_HB2 = 140288, SS_END = 157696;
__device__ __forceinline__ void phase_ssd_mfma(const Params& p, unsigned char* smem) {
    using pg8::bf16x8;
    const int tid = threadIdx.x, lane = tid & 63, wave = __builtin_amdgcn_readfirstlane(tid >> 6), fr = lane & 15, fq = lane >> 4;
    PG8_LAS unsigned char* L = (PG8_LAS unsigned char*)smem;
    PG8_LAS float* scs = (PG8_LAS float*)(L + SS_CS); PG8_LAS float* sdt = (PG8_LAS float*)(L + SS_DT);
    const bf16_t* xcl = (const bf16_t*)p.out; const bf16_t* xcc = (const bf16_t*)(p.ws + OFF_XC); const float* DT = (const float*)(p.ws + OFF_DT);
#define SSD_ROW(s_, rowp_, drow_) do { if (isctx) { const int tk_ = dir ? (CTXL - 1 - (sbase + (s_))) : (sbase + (s_)); const int gr_ = b * CTXL + tk_; rowp_ = xcc + (size_t)gr_ * 4096; drow_ = MLAT + gr_; } \
        else { const int tk_ = dir ? (SEQ - 1 - (sbase + (s_))) : (sbase + (s_)); const int gr_ = b * SEQ + tk_; rowp_ = xcl + (size_t)gr_ * 4096; drow_ = gr_; } } while (0)
#define SSD_FRAG(off_, row_, ks_) (*(const PG8_LAS bf16x8*)(L + (off_) + (row_) * SS_LD + (ks_) * 64 + fq * 16))
    for (int item = blockIdx.x; item < 256; item += gridDim.x) {
        const int xcd = item & 7, slot = item >> 3, gid = xcd * 4 + (slot >> 3), mem = slot & 7;
        const int b = gid >> 3, g = gid & 7, dir = mem >> 2, h = g * 4 + (mem & 3);
        const float Ah = -expf(p.in[11][dir * 32 + h]), dsk = p.in[12][dir * 32 + h];
        bf16_t* Y = (bf16_t*)(p.ws + (dir ? OFF_YB : OFF_YF));
        f32x4 H[4];
#pragma unroll
        for (int j = 0; j < 4; ++j) H[j] = (f32x4){0.f, 0.f, 0.f, 0.f};
        const int hi_half = wave & 1, sm = lane + 64 * hi_half, q4 = wave >> 1;
        float dt_lo, dt_hi; u32x4 xv[2], bv[4], cv[4];
#define SSD_LOAD(ckk_) do { const int ck_ = (ckk_); const bool isctx = ck_ < CTXL / 128; const int sbase = isctx ? ck_ * 128 : (ck_ - CTXL / 128) * 128; \
            const bf16_t *rl_, *rh_; int dl_, dh_; SSD_ROW(lane, rl_, dl_); SSD_ROW(lane + 64, rh_, dh_); \
            dt_lo = DT[(size_t)dl_ * 64 + dir * 32 + h]; dt_hi = DT[(size_t)dh_ * 64 + dir * 32 + h]; const bf16_t* rp_ = hi_half ? rh_ : rl_; \
            _Pragma("unroll") for (int j_ = 0; j_ < 2; ++j_) xv[j_] = *(const u32x4*)(rp_ + h * 64 + 8 * (q4 + 4 * j_)); \
            _Pragma("unroll") for (int j_ = 0; j_ < 4; ++j_) bv[j_] = *(const u32x4*)(rp_ + 2048 + g * 128 + 8 * (q4 + 4 * j_)); \
            if (!isctx) { _Pragma("unroll") for (int j_ = 0; j_ < 4; ++j_) { const bf16_t* rc_; int dc_; SSD_ROW((tid >> 4) + 32 * j_, rc_, dc_); (void)dc_; cv[j_] = *(const u32x4*)(rc_ + 3072 + g * 128 + (tid & 15) * 8); } } } while (0)
#define LBAR() do { asm volatile("s_waitcnt lgkmcnt(0)" ::: "memory"); __builtin_amdgcn_s_barrier(); asm volatile("" ::: "memory"); } while (0)
        SSD_LOAD(0);
        for (int ck = 0; ck < (CTXL + SEQ) / 128; ++ck) {
            const bool isctx = ck < CTXL / 128;
            const int sbase = isctx ? ck * 128 : (ck - CTXL / 128) * 128;
            LBAR();
            float c_lo = dt_lo * Ah, c_hi = dt_hi * Ah;
            c_lo = wave_incl_scan(c_lo); c_hi = wave_incl_scan(c_hi);
            c_hi += __int_as_float(__builtin_amdgcn_readlane(__float_as_int(c_lo), 63));
            const float c_last = __int_as_float(__builtin_amdgcn_readlane(__float_as_int(c_hi), 63));
            if (wave == 0) { scs[lane] = c_lo; scs[lane + 64] = c_hi; sdt[lane] = dt_lo; sdt[lane + 64] = dt_hi; }
            const float wsc = (hi_half ? dt_hi : dt_lo) * __expf(c_last - (hi_half ? c_hi : c_lo));
#pragma unroll
            for (int j = 0; j < 2; ++j) { const int p0 = 8 * (q4 + 4 * j); const u32x4 v = xv[j];
                PG8_LAS unsigned char* d = L + SS_XT + p0 * SS_LD + sm * 2;
                *(PG8_LAS unsigned short*)(d + 0 * SS_LD) = (unsigned short)(v.x & 0xffffu); *(PG8_LAS unsigned short*)(d + 1 * SS_LD) = (unsigned short)(v.x >> 16);
                *(PG8_LAS unsigned short*)(d + 2 * SS_LD) = (unsigned short)(v.y & 0xffffu); *(PG8_LAS unsigned short*)(d + 3 * SS_LD) = (unsigned short)(v.y >> 16);
                *(PG8_LAS unsigned short*)(d + 4 * SS_LD) = (unsigned short)(v.z & 0xffffu); *(PG8_LAS unsigned short*)(d + 5 * SS_LD) = (unsigned short)(v.z >> 16);
                *(PG8_LAS unsigned short*)(d + 6 * SS_LD) = (unsigned short)(v.w & 0xffffu); *(PG8_LAS unsigned short*)(d + 7 * SS_LD) = (unsigned short)(v.w >> 16); }
#pragma unroll
            for (int j = 0; j < 4; ++j) { const int n0 = 8 * (q4 + 4 * j); const u32x4 v = bv[j];
                if (!isctx) *(PG8_LAS u32x4*)(L + SS_B + sm * SS_LD + n0 * 2) = v;
                float f[8]; unpack8(v, f);
                PG8_LAS unsigned char* d = L + SS_BT + n0 * SS_LD + sm * 2;
#pragma unroll
                for (int e = 0; e < 8; e += 2) { const unsigned w2 = pk2(f[e] * wsc, f[e + 1] * wsc);
                    *(PG8_LAS unsigned short*)(d + e * SS_LD) = (unsigned short)(w2 & 0xffffu); *(PG8_LAS unsigned short*)(d + (e + 1) * SS_LD) = (unsigned short)(w2 >> 16); } }
            if (!isctx) {
#pragma unroll
                for (int j = 0; j < 4; ++j) *(PG8_LAS u32x4*)(L + SS_C + ((tid >> 4) + 32 * j) * SS_LD + (tid & 15) * 16) = cv[j];
            }
            if (ck + 1 < (CTXL + SEQ) / 128) SSD_LOAD(ck + 1);
            LBAR();
            f32x4 aY[4];
#define SB0() __builtin_amdgcn_sched_barrier(0)
            const int hb_rd = (ck & 1) ? SS_HB2 : SS_HB, hb_wr = (ck & 1) ? SS_HB : SS_HB2;
            const int l = 16 * wave + fr;
            if (!isctx) {
                bf16x8 cf[4];
#pragma unroll
                for (int ks = 0; ks < 4; ++ks) cf[ks] = SSD_FRAG(SS_C, l, ks);
#pragma unroll
                for (int ph = 0; ph < 2; ++ph) { bf16x8 hb[8];
#pragma unroll
                    for (int q = 0; q < 8; ++q) hb[q] = SSD_FRAG(hb_rd, 16 * (2 * ph + (q >> 2)) + fr, q & 3);
                    SB0();
                    f32x4 a0 = {0.f, 0.f, 0.f, 0.f}, a1 = a0;
#pragma unroll
                    for (int ks = 0; ks < 4; ++ks) { a0 = __builtin_amdgcn_mfma_f32_16x16x32_bf16(hb[ks], cf[ks], a0, 0, 0, 0); a1 = __builtin_amdgcn_mfma_f32_16x16x32_bf16(hb[4 + ks], cf[ks], a1, 0, 0, 0); }
                    aY[2 * ph] = a0; aY[2 * ph + 1] = a1;
                    SB0(); }
                const float csl = scs[l];
#pragma unroll
                for (int sp = 0; sp < 4; ++sp) {
                    if (2 * sp <= wave) {
                        bf16x8 bq[4], br[4];
#pragma unroll
                        for (int q = 0; q < 4; ++q) bq[q] = SSD_FRAG(SS_B, 16 * (2 * sp) + fr, q);
#pragma unroll
                        for (int q = 0; q < 4; ++q) br[q] = SSD_FRAG(SS_B, 16 * (2 * sp + 1) + fr, q);
                        const int s0 = 32 * sp + 4 * fq;
                        const f32x4 csA = *(const PG8_LAS f32x4*)(scs + s0), dtA = *(const PG8_LAS f32x4*)(sdt + s0), csB = *(const PG8_LAS f32x4*)(scs + s0 + 16), dtB = *(const PG8_LAS f32x4*)(sdt + s0 + 16);
                        SB0();
                        f32x4 a0 = {0.f, 0.f, 0.f, 0.f}, a1 = a0;
#pragma unroll
                        for (int ks = 0; ks < 4; ++ks) a0 = __builtin_amdgcn_mfma_f32_16x16x32_bf16(bq[ks], cf[ks], a0, 0, 0, 0);
#pragma unroll
                        for (int ks = 0; ks < 4; ++ks) a1 = __builtin_amdgcn_mfma_f32_16x16x32_bf16(br[ks], cf[ks], a1, 0, 0, 0);
                        float m0[4], m1[4];
#pragma unroll
                        for (int r = 0; r < 4; ++r) { const float e0 = __expf(fminf(csl - csA[r], 0.f)) * dtA[r], e1 = __expf(fminf(csl - csB[r], 0.f)) * dtB[r];
                            m0[r] = (s0 + r <= l) ? a0[r] * e0 : 0.f; m1[r] = (s0 + 16 + r <= l) ? a1[r] * e1 : 0.f; }
                        u32x2 w0, w1; w0.x = pk2(m0[0], m0[1]); w0.y = pk2(m0[2], m0[3]); w1.x = pk2(m1[0], m1[1]); w1.y = pk2(m1[2], m1[3]);
                        *(PG8_LAS u32x2*)(L + SS_C + l * SS_LD + s0 * 2) = w0; *(PG8_LAS u32x2*)(L + SS_C + l * SS_LD + (s0 + 16) * 2) = w1;
                        SB0();
                    }
                }
            }
            asm volatile("" ::: "memory");
            {
                const float dec = __expf(c_last); bf16x8 af[4];
#pragma unroll
                for (int ks = 0; ks < 4; ++ks) af[ks] = SSD_FRAG(SS_BT, l, ks);
#pragma unroll
                for (int ph = 0; ph < 2; ++ph) { bf16x8 xt[8];
#pragma unroll
                    for (int q = 0; q < 8; ++q) xt[q] = SSD_FRAG(SS_XT, 16 * (2 * ph + (q >> 2)) + fr, q & 3);
                    SB0();
                    f32x4 a0 = H[2 * ph] * dec, a1 = H[2 * ph + 1] * dec;
#pragma unroll
                    for (int ks = 0; ks < 4; ++ks) { a0 = __builtin_amdgcn_mfma_f32_16x16x32_bf16(af[ks], xt[ks], a0, 0, 0, 0); a1 = __builtin_amdgcn_mfma_f32_16x16x32_bf16(af[ks], xt[4 + ks], a1, 0, 0, 0); }
                    H[2 * ph] = a0; H[2 * ph + 1] = a1;
                    SB0(); }
                asm volatile("s_nop 15\n\ts_nop 7" : "+v"(H[0]), "+v"(H[1]), "+v"(H[2]), "+v"(H[3]));
#pragma unroll
                for (int pt = 0; pt < 4; ++pt) { u32x2 w; w.x = pk2(H[pt][0], H[pt][1]); w.y = pk2(H[pt][2], H[pt][3]); *(PG8_LAS u32x2*)(L + hb_wr + (16 * pt + fr) * SS_LD + (16 * wave + 4 * fq) * 2) = w; }
            }
            if (!isctx) {
                const float el = __expf(scs[l]);
                const int nks = ((16 * wave + 15) >> 5) + 1;
                const int tokl = dir ? (SEQ - 1 - (sbase + l)) : (sbase + l);
                bf16x8 mf[4];
#pragma unroll
                for (int ks = 0; ks < 4; ++ks) mf[ks] = SSD_FRAG(SS_C, l, (ks < nks) ? ks : 0);
#pragma unroll
                for (int ph = 0; ph < 2; ++ph) { bf16x8 xt[8]; unsigned xb[8];
#pragma unroll
                    for (int q = 0; q < 8; ++q) xt[q] = SSD_FRAG(SS_XT, 16 * (2 * ph + (q >> 2)) + fr, ((q & 3) < nks) ? (q & 3) : 0);
#pragma unroll
                    for (int q = 0; q < 8; ++q) xb[q] = *(const PG8_LAS unsigned short*)(L + SS_XT + (16 * (2 * ph + (q >> 2)) + 4 * fq + (q & 3)) * SS_LD + l * 2);
                    SB0();
#pragma unroll
                    for (int hh = 0; hh < 2; ++hh) { const int pt = 2 * ph + hh; f32x4 a = aY[pt] * el;
#pragma unroll
                        for (int ks = 0; ks < 4; ++ks) if (ks < nks) a = __builtin_amdgcn_mfma_f32_16x16x32_bf16(xt[hh * 4 + ks], mf[ks], a, 0, 0, 0);
#pragma unroll
                        for (int r = 0; r < 4; ++r) a[r] += dsk * __uint_as_float(xb[hh * 4 + r] << 16);
                        u32x2 w; w.x = pk2(a[0], a[1]); w.y = pk2(a[2], a[3]);
                        *(u32x2*)(Y + (size_t)(b * SEQ + tokl) * DM + h * 64 + 16 * pt + 4 * fq) = w; }
                    SB0(); }
            }
        }
        LBAR();
    }
#undef SSD_ROW
#undef SSD_FRAG
#undef SSD_LOAD
#undef LBAR
#undef SB0
}

__device__ __forceinline__ void phase_gate_norm(const Params& p) {
    const int lane = threadIdx.x & 63, rpb = (MLAT + (int)gridDim.x - 1) / (int)gridDim.x, rend = min(MLAT, ((int)blockIdx.x + 1) * rpb), gw = blockIdx.x * rpb + (threadIdx.x >> 6), NGW = 8;
    const bf16_t* YF = (const bf16_t*)(p.ws + OFF_YF); const bf16_t* YB = (const bf16_t*)(p.ws + OFF_YB); bf16_t* Z = (bf16_t*)(p.ws + OFF_Z); const float* nw = p.in[13];
    u32x4 ra[4], rb[4], rz[4];
    if (gw < rend) {
#pragma unroll
        for (int j = 0; j < 4; ++j) { const size_t off = (size_t)gw * DM + j * 512 + 8 * lane; ra[j] = __builtin_nontemporal_load((const u32x4*)(YF + off)); rb[j] = __builtin_nontemporal_load((const u32x4*)(YB + off)); rz[j] = __builtin_nontemporal_load((const u32x4*)(Z + off)); } }
    for (int row = gw; row < rend; row += NGW) {
        u32x4 na[4], nb[4], nz[4]; const int nrow = row + NGW;
        if (nrow < rend) {
#pragma unroll
            for (int j = 0; j < 4; ++j) { const size_t off = (size_t)nrow * DM + j * 512 + 8 * lane; na[j] = __builtin_nontemporal_load((const u32x4*)(YF + off)); nb[j] = __builtin_nontemporal_load((const u32x4*)(YB + off)); nz[j] = __builtin_nontemporal_load((const u32x4*)(Z + off)); } }
#pragma unroll
        for (int j = 0; j < 4; ++j) { const int col = j * 512 + 8 * lane; const size_t off = (size_t)row * DM + col;
            float a[8], b[8], z[8], w[8], o[8]; unpack8(ra[j], a); unpack8(rb[j], b); unpack8(rz[j], z); load8f(nw + col, w);
            float ss = 0.f;
#pragma unroll
            for (int e = 0; e < 8; ++e) { o[e] = (a[e] + b[e]) * siluf_(z[e]); ss += o[e] * o[e]; }
#pragma unroll
            for (int m = 1; m < 32; m <<= 1) ss += __shfl_xor(ss, m);
            const float rstd = rsqrtf(ss * (1.0f / 256.0f) + EPS);
#pragma unroll
            for (int e = 0; e < 8; ++e) o[e] = o[e] * rstd * w[e];
            *(u32x4*)(Z + off) = pack8(o); }
        if (nrow < rend) {
#pragma unroll
            for (int j = 0; j < 4; ++j) { ra[j] = na[j]; rb[j] = nb[j]; rz[j] = nz[j]; } }
    }
}

__device__ __forceinline__ void phase_ffn_act(const Params& p) {
    const int gtid = blockIdx.x * 512 + threadIdx.x, NT = gridDim.x * 512;
    bf16_t* A = (bf16_t*)(p.ws + OFF_UPA); const bf16_t* G = (const bf16_t*)(p.ws + OFF_UPG); const float* fw = p.in[21]; const float* fb = p.in[22];
    const u32x4 zero = {0u, 0u, 0u, 0u};
    constexpr int NCV = DFF / 8, NHL = NBATCH * 64 * 2;
    for (int task = gtid; task < NCV * NHL; task += NT) {
        const int cvi = task % NCV, hl = task / NCV, col = cvi * 8, bq = hl >> 7, gc = (hl >> 1) & 63, r0 = (hl & 1) * 32;
        float w0[8], w1[8], w2[8], b[8]; load8f(fw + col, w0); load8f(fw + DFF + col, w1); load8f(fw + 2 * DFF + col, w2); load8f(fb + col, b);
        const size_t rstride = (size_t)64 * DFF;
        size_t off = ((size_t)(bq * SEQ + r0 * 64 + gc)) * DFF + col;
        float x0[8], x1[8];
        unpack8((r0 > 0) ? *(const u32x4*)(G + off - rstride) : zero, x0); unpack8(*(const u32x4*)(G + off), x1);
#pragma unroll 4
        for (int r = r0; r < r0 + 32; ++r) {
            const u32x4 g2 = (r < 63) ? __builtin_nontemporal_load((const u32x4*)(G + off + rstride)) : zero;
            float x2[8], a[8], o[8];
            unpack8(g2, x2); unpack8(__builtin_nontemporal_load((const u32x4*)(A + off)), a);
#pragma unroll
            for (int e = 0; e < 8; e += 2) { f32x2 gv; gv.x = x0[e] * w0[e] + b[e] + x1[e] * w1[e] + x2[e] * w2[e]; gv.y = x0[e + 1] * w0[e + 1] + b[e + 1] + x1[e + 1] * w1[e + 1] + x2[e + 1] * w2[e + 1];
                const f32x2 ge = gelu_pk(gv); o[e] = ge.x * a[e]; o[e + 1] = ge.y * a[e + 1]; }
            *(u32x4*)(A + off) = pack8(o);
#pragma unroll
            for (int e = 0; e < 8; ++e) { x0[e] = x1[e]; x1[e] = x2[e]; }
            off += rstride;
        }
    }
}

__device__ __forceinline__ void phase_final_norm(const Params& p) {
    const int lane = threadIdx.x & 63, rpb = (MLAT + (int)gridDim.x - 1) / (int)gridDim.x, rend = min(MLAT, ((int)blockIdx.x + 1) * rpb), gw = blockIdx.x * rpb + (threadIdx.x >> 6), NGW = 8; const float* fw = p.in[24];
    const unsigned short* x2 = (const unsigned short*)(p.ws + OFF_UPG);
    u32x4 v[4]; f32x4 fwa[4], fwb[4];
#pragma unroll
    for (int j = 0; j < 4; ++j) { fwa[j] = *(const f32x4*)(fw + 8 * (lane + 64 * j)); fwb[j] = *(const f32x4*)(fw + 8 * (lane + 64 * j) + 4); }
    if (gw < rend) {
#pragma unroll
        for (int j = 0; j < 4; ++j) v[j] = __builtin_nontemporal_load((const u32x4*)(x2 + (size_t)gw * DM + 8 * (lane + 64 * j))); }
    for (int row = gw; row < rend; row += NGW) {
        u32x4 nv[4]; const int nrow = row + NGW;
        if (nrow < rend) {
#pragma unroll
            for (int j = 0; j < 4; ++j) nv[j] = __builtin_nontemporal_load((const u32x4*)(x2 + (size_t)nrow * DM + 8 * (lane + 64 * j))); }
        float* xr = p.out + (size_t)row * DM; float s = 0.f; f32x4 a[4], b[4];
#pragma unroll
        for (int j = 0; j < 4; ++j) { unpackh44(v[j], a[j], b[j]); s += (a[j].x * a[j].x + a[j].y * a[j].y) + (a[j].z * a[j].z + a[j].w * a[j].w) + (b[j].x * b[j].x + b[j].y * b[j].y) + (b[j].z * b[j].z + b[j].w * b[j].w); }
        const float rstd = rsqrtf(wave_sum(s) * (1.0f / DM) + EPS);
#pragma unroll
        for (int j = 0; j < 4; ++j) { const int col = 8 * (lane + 64 * j); *(f32x4*)(xr + col) = a[j] * rstd * fwa[j]; *(f32x4*)(xr + col + 4) = b[j] * rstd * fwb[j]; }
        if (nrow < rend) {
#pragma unroll
            for (int j = 0; j < 4; ++j) v[j] = nv[j]; }
    }
}

#define XB_TMO      128
#define XB_XCNT(j)  (256  + 64 * (j))
#define XB_XSUB(j)  (1280 + 64 * (j))
#define XB_XGEN(j)  (2304 + 64 * (j))
#define XB_TOP      3328
#define XB_TOPGEN   3392
#define XCD_BAR_WORDS 3456
#define XB_SPIN_CAP (1u << 20)
__device__ __forceinline__ unsigned xb_ld(unsigned* p)              { return __hip_atomic_load(p, __ATOMIC_RELAXED, __HIP_MEMORY_SCOPE_AGENT); }
__device__ __forceinline__ unsigned xb_add(unsigned* p, unsigned v) { return __hip_atomic_fetch_add(p, v, __ATOMIC_RELAXED, __HIP_MEMORY_SCOPE_AGENT); }
__device__ __forceinline__ unsigned xb_xcc_id() { return (unsigned)__builtin_amdgcn_s_getreg((3 << 11) | 20) & 0xFu; }
#define XB_SPIN(cond, bar) do { unsigned _sp = 0; while (cond) { __builtin_amdgcn_s_sleep(1); \
    if ((++_sp & 255u) == 0u) { if (xb_ld(&(bar)[XB_TMO])) break; if (_sp > XB_SPIN_CAP) { atomicAdd(&(bar)[XB_TMO], 1u); break; } } } } while (0)
struct XcdBarrier { unsigned* bar; unsigned x; volatile PG8_LAS unsigned* st; };
__device__ __forceinline__ XcdBarrier xcd_barrier_post(unsigned* bar, volatile PG8_LAS unsigned* st) {
    XcdBarrier b; b.bar = bar; b.x = xb_xcc_id(); b.st = st;
    if (threadIdx.x == 0) (void)xb_add(&bar[XB_XCNT(b.x)], 1u);
    return b;
}
__device__ __forceinline__ void xcd_barrier_complete(unsigned* bar, unsigned x, unsigned& nloc, unsigned& nx) {
    const unsigned G = gridDim.x * gridDim.y * gridDim.z;
    unsigned sum, cnt, mine, sp = 0u;
    for (;;) {
        sum = 0u; cnt = 0u; mine = 0u;
#pragma unroll
        for (unsigned j = 0; j < 16; ++j) { const unsigned c = xb_ld(&bar[XB_XCNT(j)]); sum += c; cnt += (c > 0u) ? 1u : 0u; mine = (j == x) ? c : mine; }
        if (sum == G) break;
        __builtin_amdgcn_s_sleep(1);
        if ((++sp & 255u) == 0u) { if (xb_ld(&bar[XB_TMO])) break; if (sp > XB_SPIN_CAP) { atomicAdd(&bar[XB_TMO], 1u); break; } }
    }
    nloc = mine > 0u ? mine : 1u; nx = cnt > 0u ? cnt : 1u;
}
__device__ __forceinline__ void xcd_barrier(const XcdBarrier& b) {
    asm volatile("s_waitcnt vmcnt(0)" ::: "memory");
    __syncthreads();
    if (threadIdx.x == 0) {
        unsigned* bar = b.bar;
        __builtin_amdgcn_s_waitcnt(0);
        unsigned nloc = b.st[0], nx = b.st[1];
        if (nloc == 0u) { xcd_barrier_complete(bar, b.x, nloc, nx); b.st[0] = nloc; b.st[1] = nx; }
        const unsigned old = xb_add(&bar[XB_XSUB(b.x)], 1u);
        const unsigned gen = old / nloc;
        if (old + 1u == (gen + 1u) * nloc) {
            __builtin_amdgcn_fence(__ATOMIC_RELEASE, "agent");
            asm volatile("s_waitcnt vmcnt(0)" ::: "memory");
            const unsigned og = xb_add(&bar[XB_TOP], 1u);
            const unsigned tg = og / nx;
            if (og + 1u == (tg + 1u) * nx) xb_add(&bar[XB_TOPGEN], 1u);
            else XB_SPIN(xb_ld(&bar[XB_TOPGEN]) == tg, bar);
            __builtin_amdgcn_fence(__ATOMIC_ACQUIRE, "agent");
            xb_add(&bar[XB_XGEN(b.x)], 1u);
            asm volatile("s_waitcnt vmcnt(0)" ::: "memory");
        } else {
            XB_SPIN(xb_ld(&bar[XB_XGEN(b.x)]) == gen, bar);
            __builtin_amdgcn_fence(__ATOMIC_ACQUIRE, "agent");
            asm volatile("s_waitcnt vmcnt(0)" ::: "memory");
        }
    }
    __syncthreads();
}

constexpr int NPHASES = 14;


__global__ __launch_bounds__(512, 2) void mk_fwd(Params p) {
    extern __shared__ __attribute__((aligned(16))) unsigned char smem[];
    PG8_LAS unsigned char* lds = (PG8_LAS unsigned char*)smem;
    const int lo = p.ph_lo, hi = p.ph_hi;
    const int G = (int)gridDim.x, c = (int)blockIdx.x;
    const float* mod = (const float*)(p.ws + OFF_MOD);
#define IN(k) (lo <= (k) && (k) < hi)
    volatile PG8_LAS unsigned* xst = (volatile PG8_LAS unsigned*)(lds + 157696);
    if (threadIdx.x == 0) { xst[0] = 0u; xst[1] = 0u; }
    __syncthreads();
    const XcdBarrier xb = xcd_barrier_post((unsigned*)(p.ws + OFF_BAR), xst);
#define SEAM(k) do { if (IN(k) && IN((k) + 1)) xcd_barrier(xb); } while (0)

    if (IN(0)) { phase_prologue(p, smem); } SEAM(0);
    if (IN(1)) {
        {
            pg8::Gemm g{(const bf16_t*)(p.ws + OFF_WPO), (const bf16_t*)(p.ws + OFF_WPW), DM, 512, 512, 2, nullptr, nullptr};
            pg8::Order S; S.init(DM / 256, DM / 256, G, c);
            EpiPlain E{(bf16_t*)(p.ws + OFF_WFOLD)};
            pg8::gemm_phase(lds, g, S, E);
        }
        phase_modulate(p.in[0], p.in[2], MTOT, p.in[6], mod, 0, 1, (bf16_t*)((unsigned char*)p.out + OUT_HN));
        {
            const int lane = threadIdx.x & 63, gw = c * 8 + (threadIdx.x >> 6), NGW = G * 8; const bf16_t* WU = (const bf16_t*)(p.ws + OFF_WUP); float* B2 = (float*)(p.ws + OFF_BIAS2);
            for (int n = gw; n < 2 * DFF; n += NGW) { float s0 = 0.f, s1 = 0.f, s2 = 0.f, s3 = 0.f;
#pragma unroll
                for (int j = 0; j < 4; ++j) { const int k = j * 512 + 8 * lane; float w[8], h[8]; unpack8(*(const u32x4*)(WU + (size_t)n * DM + k), w);
                    load8f(mod + 0 * 12288 + 3 * DM + k, h);
#pragma unroll
                    for (int e = 0; e < 8; ++e) s0 += w[e] * h[e];
                    load8f(mod + 1 * 12288 + 3 * DM + k, h);
#pragma unroll
                    for (int e = 0; e < 8; ++e) s1 += w[e] * h[e];
                    load8f(mod + 2 * 12288 + 3 * DM + k, h);
#pragma unroll
                    for (int e = 0; e < 8; ++e) s2 += w[e] * h[e];
                    load8f(mod + 3 * 12288 + 3 * DM + k, h);
#pragma unroll
                    for (int e = 0; e < 8; ++e) s3 += w[e] * h[e]; }
                s0 = wave_sum(s0); s1 = wave_sum(s1); s2 = wave_sum(s2); s3 = wave_sum(s3);
                if (lane == 0) { B2[n] = s0; B2[2 * DFF + n] = s1; B2[4 * DFF + n] = s2; B2[6 * DFF + n] = s3; } }
        }
    } SEAM(1);
    if (IN(2)) {
        pg8::Gemm g{(const bf16_t*)((unsigned char*)p.out + OUT_HN), (const bf16_t*)((unsigned char*)p.out + OUT_WINT), DM, DM, DM, 0, nullptr, nullptr};
        pg8::Order S; S.init(MLAT / 256, NINP / 256, G, c); S.xM0 = MLAT / 256; S.xnM = MCTX / 256; S.xn = 13; S.xlast = 48;
        EpiProj E{(bf16_t*)(p.ws + OFF_XBC), (bf16_t*)(p.ws + OFF_Z), (float*)(p.ws + OFF_DT), p.in[10]};
        pg8::gemm_phase(lds, g, S, E);
        { const int total = (MLAT / 256) * (NINP / 256) + (MCTX / 256) * 13, rem = total % G;
          if (rem == 0) phase_late_weights(p, smem, c, G); else if (c >= rem) phase_late_weights(p, smem, c - rem, G - rem); }
    } SEAM(2);
    if (IN(3)) { phase_conv_pool(p, smem); }
    SEAM(4);
    if (IN(5)) { phase_ssd_mfma(p, smem); } SEAM(5);
    if (IN(6)) { phase_gate_norm(p); } SEAM(6);
    if (IN(7)) {
        pg8::Order S; S.init(MLAT / 256, DM / 256, G, c); S.dual = 1;
        pg8::Gemm g{(const bf16_t*)(p.ws + OFF_YS), (const bf16_t*)(p.ws + OFF_WSSD), DM, DM, DM, 0, (const bf16_t*)(p.ws + OFF_P), (const bf16_t*)(p.ws + OFF_WFOLD)};
        EpiGateDual E{(bf16_t*)(p.ws + OFF_MG), (const bf16_t*)(p.ws + OFF_GS), (const bf16_t*)(p.ws + OFF_GP)};
        pg8::gemm_phase(lds, g, S, E);
    } SEAM(7);
    if (IN(8)) {
        pg8::Gemm g{(const bf16_t*)(p.ws + OFF_MG), (const bf16_t*)(p.ws + OFF_WO), DM, DM, DM, 0, nullptr, nullptr};
        pg8::Order S; S.init(MLAT / 256, DM / 256, G, c);
        EpiRes1 E{(unsigned short*)p.out, p.in[0], mod, p.in[19], (bf16_t*)(p.ws + OFF_H2), (float*)(p.ws + OFF_ROWSS)};
        pg8::gemm_phase(lds, g, S, E);
    }
    SEAM(9);
    if (IN(10)) {
        pg8::Gemm g{(const bf16_t*)(p.ws + OFF_H2), (const bf16_t*)(p.ws + OFF_WUP), DM, DM, DM, 0, nullptr, nullptr};
        pg8::Order S; S.init(MLAT / 256, 2 * DFF / 256, G, c);
        EpiUp E{(bf16_t*)(p.ws + OFF_UPA), (bf16_t*)(p.ws + OFF_UPG), (const float*)(p.ws + OFF_ROWSS), (const float*)(p.ws + OFF_BIAS2)};
        pg8::gemm_phase(lds, g, S, E);
    } SEAM(10);
    if (IN(11)) { phase_ffn_act(p); } SEAM(11);
    if (IN(12)) {
        pg8::Gemm g{(const bf16_t*)(p.ws + OFF_UPA), (const bf16_t*)(p.ws + OFF_WDN), DFF, DFF, DFF, 0, nullptr, nullptr};
        pg8::Order S; S.init(MLAT / 256, DM / 256, G, c);
        EpiRes E{(unsigned short*)(p.ws + OFF_UPG), (const unsigned short*)p.out, mod + 5 * DM};
        pg8::gemm_phase(lds, g, S, E);
    } SEAM(12);
    if (IN(13)) { phase_final_norm(p); }
    if (hi > NPHASES + 1000) cg::this_grid().sync();
#undef IN
#undef SEAM
}

extern "C" void kernel_launch(void* const* d_in, const int* in_sizes, int n_in, void* d_out, int out_size, void* d_ws, size_t ws_size, hipStream_t stream) {
    static int grid = 0;
    if (grid == 0) {
        if (n_in != 25 || out_size != MLAT * DM || ws_size < WS_END) { fprintf(stderr, "kernel_launch: unexpected shapes (n_in %d out %d ws %zu need %zu)\n", n_in, out_size, ws_size, (size_t)WS_END); grid = -1; return; }
        int dev = 0, cus = 0, per_cu = 0;
        (void)hipGetDevice(&dev); (void)hipDeviceGetAttribute(&cus, hipDeviceAttributeMultiprocessorCount, dev);
        if (hipFuncSetAttribute((const void*)mk_fwd, hipFuncAttributeMaxDynamicSharedMemorySize, LDS_BYTES) != hipSuccess) { fprintf(stderr, "kernel_launch: hipFuncSetAttribute failed\n"); grid = -1; return; }
        if (hipOccupancyMaxActiveBlocksPerMultiprocessor(&per_cu, (const void*)mk_fwd, 512, LDS_BYTES) != hipSuccess || per_cu < 1) per_cu = 1;
        (void)hipGetLastError();
        grid = cus * per_cu;
        if (grid <= 0) grid = 256;
    }
    if (grid < 0) return;
    (void)hipMemsetAsync((unsigned char*)d_ws + OFF_MOD, 0, OFF_DT, stream);
    Params p{};
    for (int i = 0; i < 25; ++i) p.in[i] = (const float*)d_in[i];
    p.out = (float*)d_out; p.ws = (unsigned char*)d_ws;
#if MK_MULTI
    for (int ph = 0; ph < NPHASES; ++ph) { p.ph_lo = ph; p.ph_hi = ph + 1; hipLaunchKernelGGL(mk_fwd, dim3(grid), dim3(512), LDS_BYTES, stream, p); }
#else
    p.ph_lo = 0; p.ph_hi = NPHASES;
    void* args[] = {&p};
    hipError_t e = hipLaunchCooperativeKernel((const void*)mk_fwd, dim3(grid), dim3(512), args, LDS_BYTES, stream);
    if (e != hipSuccess) fprintf(stderr, "cooperative launch failed: %s (grid %d)\n", hipGetErrorString(e), grid);
#ifdef PROBE_EXTRA
    { const int extra[] = PROBE_EXTRA; for (int ph : extra) { p.ph_lo = ph; p.ph_hi = ph + 1; hipLaunchKernelGGL(mk_fwd, dim3(grid), dim3(512), LDS_BYTES, stream, p); } }
#endif
#endif
}
```

```cpp
#include <hip/hip_runtime.h>
#include <hip/hip_cooperative_groups.h>
#include <cstdio>
#include <cstdint>
namespace cg = cooperative_groups;

#ifndef MK_MULTI
#define MK_MULTI 0
#endif

namespace pg8 {
#define PG8_LAS __attribute__((address_space(3)))
typedef unsigned short bf16_t;
typedef short bf16x8 __attribute__((ext_vector_type(8)));
typedef float f32x4 __attribute__((ext_vector_type(4)));
typedef unsigned u32x4 __attribute__((ext_vector_type(4)));
constexpr int BM = 256, BK = 64, HALF = 128, HTB = HALF * BK * 2, STAGE_BYTES = 8 * HTB, NXCD = 8, WGM = 2;

__host__ __device__ __forceinline__ int lds_byte(int r, int c) { const int st = (r >> 4) * 2 + (c >> 5), rr = r & 15, cc = c & 31, ob = rr * 64 + cc * 2; return st * 1024 + (ob ^ (((ob >> 9) & 1) << 5)); }
__host__ __device__ __forceinline__ void stage_rc(int b, int& R, int& C) { const int st = b / 1024, sb = b % 1024, swz = sb ^ (((sb >> 9) & 1) << 5); R = (st >> 1) * 16 + swz / 64; C = (st & 1) * 32 + (swz % 64) / 2; }
__host__ __device__ __forceinline__ int perm32(int rho) { const int n = rho >> 4, i = rho & 15; return 8 * (i >> 2) + 4 * n + (i & 3); }

struct Unit { int pm, pn, half; };
struct Gemm { const bf16_t* A; const bf16_t* Bt; int lda, ldb, K, agrp; const bf16_t* A2; const bf16_t* Bt2; };

struct Order {
    int nM, nN, nwg, G, c, xM0, xnM, xn, xlast, dual;
    __device__ void init(int nM_, int nN_, int G_, int c_) { nM = nM_; nN = nN_; nwg = nM * nN; G = G_; c = c_; xM0 = 0; xnM = 0; xn = 0; xlast = 0; dual = 0; }
    __device__ bool next(int i_, Unit& u) const {
        const int i = dual ? (i_ >> 1) : i_; u.half = dual ? (i_ & 1) : 0;
        const long L = (long)i * G + c;
        if (L >= nwg) { const int e = (int)(L - nwg); if (e >= xnM * xn) return false; const int j = e / xnM; u.pm = xM0 + e % xnM; u.pn = (j < xn - 1) ? j : xlast; return true; }
        int wgid = (int)L; { const int q = nwg / NXCD, r = nwg % NXCD, xcd = wgid % NXCD, off = wgid / NXCD; wgid = (xcd < r ? xcd * (q + 1) : r * (q + 1) + (xcd - r) * q) + off; }
        const int nig = WGM * nN, gid = wgid / nig, fm = gid * WGM, gsz = (nM - fm) < WGM ? (nM - fm) : WGM;
        u.pm = fm + ((wgid % nig) % gsz); u.pn = (wgid % nig) / gsz; return true;
    }
};

__device__ __forceinline__ unsigned cvt_pk_bf16(float lo, float hi) { unsigned r; asm volatile("v_cvt_pk_bf16_f32 %0, %1, %2" : "=v"(r) : "v"(lo), "v"(hi)); return r; }

template <class Epi, class Sched>
__device__ __forceinline__ void gemm_phase(PG8_LAS unsigned char* lds, const Gemm g, const Sched& S, const Epi& E) {
    const int tid = threadIdx.x, wid = __builtin_amdgcn_readfirstlane(tid >> 6), lane = tid & 63, wr = wid >> 2, wc = wid & 3, fr = lane & 15, fq = lane >> 4;
    const int K = g.K, nt = K / BK;
    unsigned voffA[2], voffB[2];
#pragma unroll
    for (int i = 0; i < 2; ++i) { int R, C; stage_rc(tid * 16 + i * 8192, R, C); const int Rb = (R & ~31) + perm32(R & 31);
        voffA[i] = (unsigned)(R * g.lda + C) * 2u; voffB[i] = (unsigned)(Rb * g.ldb + C) * 2u; }
    const size_t kstep = (size_t)(BK * 2);
    const size_t hstepA = (size_t)HALF * g.lda * 2, hstepB = (size_t)HALF * g.ldb * 2;
    const size_t tstepA = 2 * hstepA, tstepB = 2 * hstepB;
    const unsigned ldsw = (unsigned)wid * 1024u;
    const int aoff = lds_byte(wr * 64 + fr, fq * 8), boff = lds_byte(wc * 32 + fr, fq * 8);
#define PG8_SA(b, h) (((b) * 2 + (h)) * HTB)
#define PG8_SB(b, h) ((4 + (b) * 2 + (h)) * HTB)
#define PG8_STAGE(bufoff, gbase, voff) do { _Pragma("unroll") for (int _i = 0; _i < 2; ++_i) \
        __builtin_amdgcn_global_load_lds((const unsigned*)((const char*)(gbase) + (voff)[_i]), (PG8_LAS unsigned*)(lds + (bufoff) + ldsw + _i * 8192), 16, 0, 0); } while (0)
#define PG8_LDA(dst, b, h) do { _Pragma("unroll") for (int m = 0; m < 4; ++m) _Pragma("unroll") for (int k = 0; k < 2; ++k) dst[m][k] = *(const PG8_LAS bf16x8*)(lds + PG8_SA(b, h) + aoff + m * 2048 + k * 1024); } while (0)
#define PG8_LDB(dst, b, h) do { _Pragma("unroll") for (int n = 0; n < 2; ++n) _Pragma("unroll") for (int k = 0; k < 2; ++k) dst[n][k] = *(const PG8_LAS bf16x8*)(lds + PG8_SB(b, h) + boff + n * 2048 + k * 1024); } while (0)
#define PG8_MMA(ai, bj, At, Bt) do { __builtin_amdgcn_s_setprio(1); _Pragma("unroll") for (int m = 0; m < 4; ++m) _Pragma("unroll") for (int n = 0; n < 2; ++n) _Pragma("unroll") for (int k = 0; k < 2; ++k) \
        acc[ai][bj][m][n] = __builtin_amdgcn_mfma_f32_16x16x32_bf16(Bt[n][k], At[m][k], acc[ai][bj][m][n], 0, 0, 0); __builtin_amdgcn_s_setprio(0); } while (0)
#define PG8_WAIT_V(n) asm volatile("s_waitcnt vmcnt(" #n ")" ::: "memory")
#define PG8_WAIT_L(n) asm volatile("s_waitcnt lgkmcnt(" #n ")" ::: "memory")
#define PG8_BAR __builtin_amdgcn_s_barrier()
#define PG8_SCHED __builtin_amdgcn_sched_barrier(0)
#define PG8_ABASE(u) ((const char*)((u).half ? g.A2 : g.A) + (size_t)(u).pm * tstepA + (g.agrp ? (size_t)((u).pn / g.agrp) * (size_t)K * 2 : (size_t)0))
#define PG8_BBASE(u) ((const char*)((u).half ? g.Bt2 : g.Bt) + (size_t)(u).pn * tstepB)
    Unit cur, nxt; int ui = 0;
    if (!S.next(0, cur)) return;
    f32x4 acc[2][2][4][2];
#pragma unroll
    for (int a = 0; a < 2; ++a)
#pragma unroll
        for (int b = 0; b < 2; ++b)
#pragma unroll
            for (int m = 0; m < 4; ++m)
#pragma unroll
                for (int n = 0; n < 2; ++n) acc[a][b][m][n] = (f32x4){0.f, 0.f, 0.f, 0.f};
    bf16x8 At[4][2], B0[2][2], B1[2][2];
    const char* cA = PG8_ABASE(cur); const char* cB = PG8_BBASE(cur);
    PG8_STAGE(PG8_SB(0, 0), cB, voffB); PG8_STAGE(PG8_SB(0, 1), cB + hstepB, voffB); PG8_STAGE(PG8_SA(0, 0), cA, voffA); PG8_STAGE(PG8_SA(0, 1), cA + hstepA, voffA);
    if (wr == 1) PG8_BAR;
    PG8_WAIT_V(2); PG8_BAR;
    PG8_STAGE(PG8_SB(1, 0), cB + kstep, voffB); PG8_STAGE(PG8_SA(1, 0), cA + kstep, voffA); PG8_STAGE(PG8_SB(1, 1), cB + hstepB + kstep, voffB);
    PG8_WAIT_V(6); PG8_BAR;
    for (;;) {
        const bool has_next = S.next(ui + 1, nxt);
        const char* nA = has_next ? PG8_ABASE(nxt) : cA; const char* nB = has_next ? PG8_BBASE(nxt) : cB;
        for (int t = 0; t < nt; t += 2) {
            const bool last = (t == nt - 2);
            const char* a1 = cA + (size_t)(t + 1) * kstep;
            const char* a2 = last ? nA : cA + (size_t)(t + 2) * kstep; const char* b2 = last ? nB : cB + (size_t)(t + 2) * kstep;
            const char* a3 = a2 + kstep; const char* b3 = b2 + kstep;
            PG8_LDB(B0, 0, 0); PG8_LDB(B1, 0, 1); PG8_SCHED; PG8_LDA(At, 0, 0); PG8_STAGE(PG8_SA(1, 1), a1 + hstepA, voffA);
            PG8_WAIT_V(8); PG8_WAIT_L(0); PG8_BAR; PG8_MMA(0, 0, At, B0); PG8_MMA(0, 1, At, B1); PG8_BAR; PG8_SCHED;
            PG8_LDA(At, 0, 1); PG8_STAGE(PG8_SB(0, 0), b2, voffB); PG8_STAGE(PG8_SB(0, 1), b2 + hstepB, voffB); PG8_STAGE(PG8_SA(0, 0), a2, voffA);
            PG8_WAIT_V(8); PG8_WAIT_L(0); PG8_BAR; PG8_MMA(1, 0, At, B0); PG8_MMA(1, 1, At, B1); PG8_BAR; PG8_SCHED;
            PG8_LDB(B0, 1, 0); PG8_LDB(B1, 1, 1); PG8_SCHED; PG8_LDA(At, 1, 0); PG8_STAGE(PG8_SA(0, 1), a2 + hstepA, voffA);
            PG8_WAIT_V(8); PG8_WAIT_L(0); PG8_BAR; PG8_MMA(0, 0, At, B0); PG8_MMA(0, 1, At, B1); PG8_BAR; PG8_SCHED;
            PG8_LDA(At, 1, 1); PG8_STAGE(PG8_SB(1, 0), b3, voffB); PG8_STAGE(PG8_SB(1, 1), b3 + hstepB, voffB); PG8_STAGE(PG8_SA(1, 0), a3, voffA);
            PG8_WAIT_V(8); PG8_WAIT_L(0); PG8_BAR; PG8_MMA(1, 0, At, B0); PG8_MMA(1, 1, At, B1); PG8_BAR; PG8_SCHED;
        }
        if (wr == 0) PG8_BAR;
        asm volatile("s_nop 15\n\ts_nop 7" ::: "memory");
        const bool keep = E(acc, cur, wr, wc, fr, fq);
        if (!has_next) break;
        if (!keep)
#pragma unroll
        for (int a = 0; a < 2; ++a)
#pragma unroll
            for (int b = 0; b < 2; ++b)
#pragma unroll
                for (int m = 0; m < 4; ++m)
#pragma unroll
                    for (int n = 0; n < 2; ++n) acc[a][b][m][n] = (f32x4){0.f, 0.f, 0.f, 0.f};
        cur = nxt; cA = nA; cB = nB; ++ui;
        if (wr == 1) PG8_BAR;
    }
    PG8_WAIT_V(0);
    PG8_BAR;
#undef PG8_SA
#undef PG8_SB
#undef PG8_STAGE
#undef PG8_LDA
#undef PG8_LDB
#undef PG8_MMA
#undef PG8_WAIT_V
#undef PG8_WAIT_L
#undef PG8_BAR
#undef PG8_SCHED
#undef PG8_ABASE
#undef PG8_BBASE
}
}

using pg8::bf16_t; using pg8::f32x4; using pg8::u32x4; using pg8::Unit;
typedef unsigned u32x2 __attribute__((ext_vector_type(2)));

constexpr int DM = 2048, NBATCH = 4, SEQ = 4096, MLAT = NBATCH * SEQ, CTXL = 256, MCTX = NBATCH * CTXL, MTOT = MLAT + MCTX;
constexpr int DFF = 5632, NIN = 12352, NINP = 12544, NXBC = 4096;
constexpr float EPS = 1e-6f;
constexpr int LDS_BYTES = 157696 + 16;

constexpr size_t OFF_MOD = 0;
constexpr size_t OFF_BAR = 245760;
constexpr size_t OFF_ROWSS = 262144;
constexpr size_t OFF_DT = 327680;
constexpr size_t OFF_XC = OFF_DT + (size_t)MTOT * 64 * 4;
constexpr size_t OFF_WUP = OFF_XC + (size_t)MCTX * 4096 * 2;
constexpr size_t OFF_WDN = OFF_WUP + (size_t)2 * DFF * DM * 2;
constexpr size_t OFF_WSSD = OFF_WDN + (size_t)DM * DFF * 2;
constexpr size_t OFF_WPO = OFF_WSSD + (size_t)DM * DM * 2;
constexpr size_t OFF_WO = OFF_WPO + (size_t)DM * DM * 2;
constexpr size_t OFF_WPW = OFF_WO + (size_t)DM * DM * 2;
constexpr size_t OFF_XBC = OFF_WPW + (size_t)2048 * 512 * 2;
constexpr size_t SZ_ACT = (size_t)MLAT * DM * 2;
constexpr size_t OFF_Z = OFF_XBC + (size_t)MTOT * 4096 * 2;
constexpr size_t OFF_V = OFF_Z + SZ_ACT;
constexpr size_t OFF_GS = OFF_V + SZ_ACT;
constexpr size_t OFF_GP = OFF_GS + SZ_ACT;
constexpr size_t OFF_WFOLD = OFF_GP + SZ_ACT;
constexpr size_t OFF_BIAS2 = OFF_WFOLD + (size_t)DM * DM * 2;
constexpr size_t WS_END = OFF_BIAS2 + (size_t)4 * 2 * DFF * 4;
constexpr size_t OFF_P = OFF_V;
constexpr size_t OFF_YF = OFF_XBC + SZ_ACT, OFF_YB = OFF_XBC, OFF_YS = OFF_Z, OFF_T1 = OFF_V, OFF_MG = OFF_XBC, OFF_H2 = OFF_GP;
constexpr size_t OFF_UPA = OFF_WSSD;
constexpr size_t OFF_UPG = OFF_UPA + (size_t)MLAT * DFF * 2;
static_assert(OFF_UPG + (size_t)MLAT * DFF * 2 <= OFF_H2, "up buffers overlap h2");
constexpr size_t OUT_HN = 0;
constexpr size_t OUT_WINT = (size_t)MTOT * DM * 2;
static_assert(OUT_WINT + (size_t)NINP * DM * 2 <= (size_t)MLAT * DM * 4, "d_out overlay");

struct Params { const float* in[25]; float* out; unsigned char* ws; int ph_lo, ph_hi; };

__device__ __forceinline__ float bflo(unsigned u) { return __uint_as_float(u << 16); }
__device__ __forceinline__ float bfhi(unsigned u) { return __uint_as_float(u & 0xffff0000u); }
__device__ __forceinline__ unsigned pk2(float lo, float hi) { return pg8::cvt_pk_bf16(lo, hi); }
__device__ __forceinline__ void unpack8(const u32x4 r, float (&o)[8]) { o[0] = bflo(r.x); o[1] = bfhi(r.x); o[2] = bflo(r.y); o[3] = bfhi(r.y); o[4] = bflo(r.z); o[5] = bfhi(r.z); o[6] = bflo(r.w); o[7] = bfhi(r.w); }
__device__ __forceinline__ u32x4 pack8(const float (&o)[8]) { u32x4 r; r.x = pk2(o[0], o[1]); r.y = pk2(o[2], o[3]); r.z = pk2(o[4], o[5]); r.w = pk2(o[6], o[7]); return r; }
typedef _Float16 h16x2 __attribute__((ext_vector_type(2)));
__device__ __forceinline__ unsigned pkh2(float lo, float hi) { h16x2 v; v.x = (_Float16)lo; v.y = (_Float16)hi; return __builtin_bit_cast(unsigned, v); }
__device__ __forceinline__ u32x4 packh44(const f32x4 a, const f32x4 b) { u32x4 w; w.x = pkh2(a[0], a[1]); w.y = pkh2(a[2], a[3]); w.z = pkh2(b[0], b[1]); w.w = pkh2(b[2], b[3]); return w; }
__device__ __forceinline__ void unpackh44(const u32x4 r, f32x4& a, f32x4& b) {
    const unsigned r0 = r.x, r1 = r.y, r2 = r.z, r3 = r.w;
    const h16x2 p0 = __builtin_bit_cast(h16x2, r0), p1 = __builtin_bit_cast(h16x2, r1), p2 = __builtin_bit_cast(h16x2, r2), p3 = __builtin_bit_cast(h16x2, r3);
    a = (f32x4){(float)p0.x, (float)p0.y, (float)p1.x, (float)p1.y}; b = (f32x4){(float)p2.x, (float)p2.y, (float)p3.x, (float)p3.y}; }
__device__ __forceinline__ float wave_sum(float v) {
#pragma unroll
    for (int o = 1; o < 64; o <<= 1) v += __shfl_xor(v, o);
    return v;
}
__device__ __forceinline__ float wave_incl_scan(float x) {
#define DPP_ADD(ctrl_, rmask_) x += __int_as_float(__builtin_amdgcn_update_dpp(0, __float_as_int(x), ctrl_, rmask_, 0xf, false))
    DPP_ADD(0x111, 0xf); DPP_ADD(0x112, 0xf); DPP_ADD(0x114, 0xf); DPP_ADD(0x118, 0xf); DPP_ADD(0x142, 0xa); DPP_ADD(0x143, 0xc);
#undef DPP_ADD
    return x;
}
__device__ __forceinline__ float sigmoidf_(float x) { return __builtin_amdgcn_rcpf(1.0f + __expf(-x)); }
__device__ __forceinline__ float siluf_(float x) { return x * __builtin_amdgcn_rcpf(1.0f + __expf(-x)); }
typedef float f32x2 __attribute__((ext_vector_type(2)));
__device__ __forceinline__ f32x2 gelu_pk(f32x2 v) {
    const f32x2 av = __builtin_elementwise_abs(v), d = av * 0.2316418882f + 1.0f;
    f32x2 t; t.x = __builtin_amdgcn_rcpf(d.x); t.y = __builtin_amdgcn_rcpf(d.y);
    f32x2 q = t * 0.5307027145f + (-0.7265760135f); q = q * t + 0.7107068705f; q = q * t + (-0.142248368f); q = q * t + 0.127414796f; q = q * t;
    const f32x2 s = (v * v) * (-0.72134752044f);
    f32x2 e; e.x = __builtin_amdgcn_exp2f(s.x); e.y = __builtin_amdgcn_exp2f(s.y);
    const f32x2 m = v * (q * e), r = v - m;
    f32x2 o; o.x = v.x < 0.f ? m.x : r.x; o.y = v.y < 0.f ? m.y : r.y; return o;
}
__device__ __forceinline__ float softplusf_(float x) { return fmaxf(x, 0.f) + log1pf(__expf(-fabsf(x))); }
__device__ __forceinline__ void load8f(const float* p, float (&o)[8]) { const f32x4 a = *(const f32x4*)p, b = *(const f32x4*)(p + 4); o[0] = a.x; o[1] = a.y; o[2] = a.z; o[3] = a.w; o[4] = b.x; o[5] = b.y; o[6] = b.z; o[7] = b.w; }

#define EPI_LOOP_BEGIN \
    const int row0 = u.pm * 256 + wr * 64 + fr, cl0 = wc * 32 + 8 * fq; \
    _Pragma("unroll") for (int ai = 0; ai < 2; ++ai) _Pragma("unroll") for (int m = 0; m < 4; ++m) { const int row = row0 + ai * 128 + m * 16; \
    _Pragma("unroll") for (int bj = 0; bj < 2; ++bj) { const int cl = cl0 + bj * 128; const f32x4 v0 = acc[ai][bj][m][0], v1 = acc[ai][bj][m][1];
#define EPI_LOOP_END } }
__device__ __forceinline__ u32x4 pack44(const f32x4 a, const f32x4 b) { u32x4 w; w.x = pk2(a[0], a[1]); w.y = pk2(a[2], a[3]); w.z = pk2(b[0], b[1]); w.w = pk2(b[2], b[3]); return w; }

struct EpiProj {
    bf16_t* xbc; bf16_t* zvg; float* dt; const float* dt_bias;
    __device__ __forceinline__ bool operator()(f32x4 (&acc)[2][2][4][2], const Unit& u, int wr, int wc, int fr, int fq) const {
        if (u.pn < 16) {
            EPI_LOOP_BEGIN *(u32x4*)(xbc + (size_t)row * 4096 + u.pn * 256 + cl) = pack44(v0, v1); EPI_LOOP_END
        } else if (u.pn < 48) {
            bf16_t* base = zvg + (size_t)((u.pn - 16) >> 3) * ((size_t)MLAT * DM) + ((u.pn - 16) & 7) * 256;
            EPI_LOOP_BEGIN *(u32x4*)(base + (size_t)row * DM + cl) = pack44(v0, v1); EPI_LOOP_END
        } else {
            EPI_LOOP_BEGIN
                if (cl < 64) { const f32x4 b0 = *(const f32x4*)(dt_bias + cl), b1 = *(const f32x4*)(dt_bias + cl + 4); f32x4 o0, o1;
#pragma unroll
                    for (int e = 0; e < 4; ++e) { o0[e] = softplusf_(v0[e] + b0[e]); o1[e] = softplusf_(v1[e] + b1[e]); }
                    *(f32x4*)(dt + (size_t)row * 64 + cl) = o0; *(f32x4*)(dt + (size_t)row * 64 + cl + 4) = o1; }
            EPI_LOOP_END
        }
        return false;
    }
};
struct EpiPlain {
    bf16_t* o;
    __device__ __forceinline__ bool operator()(f32x4 (&acc)[2][2][4][2], const Unit& u, int wr, int wc, int fr, int fq) const {
        EPI_LOOP_BEGIN *(u32x4*)(o + (size_t)row * DM + u.pn * 256 + cl) = pack44(v0, v1); EPI_LOOP_END
        return false;
    }
};
struct EpiScale {
    bf16_t* o; const float* scale;
    __device__ __forceinline__ bool operator()(f32x4 (&acc)[2][2][4][2], const Unit& u, int wr, int wc, int fr, int fq) const {
        EPI_LOOP_BEGIN const int col = u.pn * 256 + cl; const f32x4 s0 = *(const f32x4*)(scale + col), s1 = *(const f32x4*)(scale + col + 4);
            *(u32x4*)(o + (size_t)row * DM + col) = pack44(v0 * s0, v1 * s1); EPI_LOOP_END
        return false;
    }
};
template <int SECOND> struct EpiGate {
    bf16_t* o; const bf16_t* gate; const bf16_t* t1;
    __device__ __forceinline__ bool operator()(f32x4 (&acc)[2][2][4][2], const Unit& u, int wr, int wc, int fr, int fq) const {
        EPI_LOOP_BEGIN const size_t off = (size_t)row * DM + u.pn * 256 + cl; float gt[8]; unpack8(*(const u32x4*)(gate + off), gt);
            float r[8];
#pragma unroll
            for (int e = 0; e < 4; ++e) { r[e] = sigmoidf_(gt[e]) * v0[e]; r[4 + e] = sigmoidf_(gt[4 + e]) * v1[e]; }
            if (SECOND) { float pv[8]; unpack8(*(const u32x4*)(t1 + off), pv);
#pragma unroll
                for (int e = 0; e < 8; ++e) r[e] += pv[e]; }
            *(u32x4*)(o + off) = pack8(r); EPI_LOOP_END
        return false;
    }
};
struct EpiGateDual {
    bf16_t* o; const bf16_t* gs; const bf16_t* gp;
    __device__ __forceinline__ bool operator()(f32x4 (&acc)[2][2][4][2], const Unit& u, int wr, int wc, int fr, int fq) const {
        const int row0 = u.pm * 256 + wr * 64 + fr, cl0 = wc * 32 + 8 * fq;
        if (u.half == 0) {
#pragma unroll
            for (int ai = 0; ai < 2; ++ai)
#pragma unroll
                for (int m = 0; m < 4; ++m)
#pragma unroll
                    for (int bj = 0; bj < 2; ++bj) { const size_t off = (size_t)(row0 + ai * 128 + m * 16) * DM + u.pn * 256 + cl0 + bj * 128;
                        float a[8], b[8]; unpack8(__builtin_nontemporal_load((const u32x4*)(gs + off)), a); unpack8(__builtin_nontemporal_load((const u32x4*)(gp + off)), b);
#pragma unroll
                        for (int e = 0; e < 4; ++e) { acc[ai][bj][m][0][e] *= (1.0f + __expf(-b[e])) * __builtin_amdgcn_rcpf(1.0f + __expf(-a[e]));
                                                      acc[ai][bj][m][1][e] *= (1.0f + __expf(-b[4 + e])) * __builtin_amdgcn_rcpf(1.0f + __expf(-a[4 + e])); } }
            return true;
        }
#pragma unroll
        for (int ai = 0; ai < 2; ++ai)
#pragma unroll
            for (int m = 0; m < 4; ++m)
#pragma unroll
                for (int bj = 0; bj < 2; ++bj) { const size_t off = (size_t)(row0 + ai * 128 + m * 16) * DM + u.pn * 256 + cl0 + bj * 128;
                    float b[8], r[8]; unpack8(__builtin_nontemporal_load((const u32x4*)(gp + off)), b);
#pragma unroll
                    for (int e = 0; e < 4; ++e) { r[e] = acc[ai][bj][m][0][e] * sigmoidf_(b[e]); r[4 + e] = acc[ai][bj][m][1][e] * sigmoidf_(b[4 + e]); }
                    *(u32x4*)(o + off) = pack8(r); }
        return false;
    }
};
struct EpiRes {
    unsigned short* o; const unsigned short* base; const float* gate;
    __device__ __forceinline__ bool operator()(f32x4 (&acc)[2][2][4][2], const Unit& u, int wr, int wc, int fr, int fq) const {
        const float* gp0 = gate + (size_t)((u.pm * 256) >> 12) * 12288 + u.pn * 256 + wc * 32 + 8 * fq;
        const f32x4 ga0 = *(const f32x4*)gp0, ga1 = *(const f32x4*)(gp0 + 4), gb0 = *(const f32x4*)(gp0 + 128), gb1 = *(const f32x4*)(gp0 + 132);
        EPI_LOOP_BEGIN const int col = u.pn * 256 + cl; const size_t off = (size_t)row * DM + col;
            const f32x4 g0 = bj ? gb0 : ga0, g1 = bj ? gb1 : ga1; f32x4 x0, x1; unpackh44(__builtin_nontemporal_load((const u32x4*)(base + off)), x0, x1);
            *(u32x4*)(o + off) = packh44(x0 + g0 * v0, x1 + g1 * v1); EPI_LOOP_END
        return false;
    }
};
struct EpiRes1 {
    unsigned short* o; const float* base; const float* mod; const float* n2w; bf16_t* xm; float* rowss;
    __device__ __forceinline__ bool operator()(f32x4 (&acc)[2][2][4][2], const Unit& u, int wr, int wc, int fr, int fq) const {
        const int row0 = u.pm * 256 + wr * 64 + fr, cl0 = wc * 32 + 8 * fq; const float* mr = mod + (size_t)(row0 >> 12) * 12288;
        f32x4 hg[2][2], hw[2][2];
#pragma unroll
        for (int bj = 0; bj < 2; ++bj) { const int col = u.pn * 256 + cl0 + bj * 128;
            hg[bj][0] = *(const f32x4*)(mr + 2 * DM + col); hg[bj][1] = *(const f32x4*)(mr + 2 * DM + col + 4);
            hw[bj][0] = *(const f32x4*)(n2w + col) * (*(const f32x4*)(mr + 4 * DM + col) + 1.0f); hw[bj][1] = *(const f32x4*)(n2w + col + 4) * (*(const f32x4*)(mr + 4 * DM + col + 4) + 1.0f); }
#pragma unroll
        for (int ai = 0; ai < 2; ++ai)
#pragma unroll
            for (int m = 0; m < 4; ++m) { const int row = row0 + ai * 128 + m * 16; float ss = 0.f;
#pragma unroll
                for (int bj = 0; bj < 2; ++bj) { const int col = u.pn * 256 + cl0 + bj * 128; const size_t off = (size_t)row * DM + col;
                    const f32x4 g0 = hg[bj][0], g1 = hg[bj][1], x0 = __builtin_nontemporal_load((const f32x4*)(base + off)), x1 = __builtin_nontemporal_load((const f32x4*)(base + off + 4));
                    const f32x4 r0 = x0 + g0 * acc[ai][bj][m][0], r1 = x1 + g1 * acc[ai][bj][m][1];
                    *(u32x4*)(o + off) = packh44(r0, r1);
                    ss += (r0.x * r0.x + r0.y * r0.y) + (r0.z * r0.z + r0.w * r0.w) + (r1.x * r1.x + r1.y * r1.y) + (r1.z * r1.z + r1.w * r1.w);
                    const f32x4 w0 = hw[bj][0], w1 = hw[bj][1];
                    *(u32x4*)(xm + off) = pack44(r0 * w0, r1 * w1); }
                ss += __shfl_xor(ss, 16); ss += __shfl_xor(ss, 32);
                if (fq == 0) atomicAdd(rowss + row, ss); }
        return false;
    }
};
struct EpiUp {
    bf16_t* a; bf16_t* g; const float* rowss; const float* bias2;
    __device__ __forceinline__ bool operator()(f32x4 (&acc)[2][2][4][2], const Unit& u, int wr, int wc, int fr, int fq) const {
        bf16_t* base = (u.pn < 22) ? a + u.pn * 256 : g + (u.pn - 22) * 256;
        const int row0 = u.pm * 256 + wr * 64 + fr, cl0 = wc * 32 + 8 * fq; const float* bb = bias2 + (size_t)(row0 >> 12) * (2 * DFF) + u.pn * 256 + cl0;
        const f32x4 b00 = *(const f32x4*)bb, b01 = *(const f32x4*)(bb + 4), b10 = *(const f32x4*)(bb + 128), b11 = *(const f32x4*)(bb + 132);
#pragma unroll
        for (int ai = 0; ai < 2; ++ai)
#pragma unroll
            for (int m = 0; m < 4; ++m) { const int row = row0 + ai * 128 + m * 16; const float rstd = rsqrtf(rowss[row] * (1.0f / DM) + EPS);
                *(u32x4*)(base + (size_t)row * DFF + cl0) = pack44(acc[ai][0][m][0] * rstd + b00, acc[ai][0][m][1] * rstd + b01);
                *(u32x4*)(base + (size_t)row * DFF + cl0 + 128) = pack44(acc[ai][1][m][0] * rstd + b10, acc[ai][1][m][1] * rstd + b11); }
        return false;
    }
};

#define LDS_WAIT() asm volatile("s_waitcnt lgkmcnt(0)" ::: "memory")

__device__ __forceinline__ void transpose_item(const float* W, int N, int k0, int n0, bf16_t* WT, int ldt, int dst_row0, float* scr, int lane) {
    float tv[32];
#pragma unroll
    for (int i = 0; i < 32; ++i) tv[i] = W[(size_t)(k0 + 2 * i + (lane >> 5)) * N + n0 + (lane & 31)];
#pragma unroll
    for (int i = 0; i < 32; ++i) scr[(2 * i + (lane >> 5)) * 33 + (lane & 31)] = tv[i];
    LDS_WAIT();
    const int c = lane & 7;
#pragma unroll
    for (int j = 0; j < 4; ++j) { const int n = (lane >> 3) + 8 * j; const float* s = scr + (8 * c) * 33 + n;
        u32x4 o; o.x = pk2(s[0 * 33], s[1 * 33]); o.y = pk2(s[2 * 33], s[3 * 33]); o.z = pk2(s[4 * 33], s[5 * 33]); o.w = pk2(s[6 * 33], s[7 * 33]);
        *(u32x4*)(WT + (size_t)(dst_row0 + n) * ldt + k0 + 8 * c) = o; }
    LDS_WAIT();
}

__device__ __forceinline__ void phase_prologue(const Params& p, unsigned char* smem) {
    const int tid = threadIdx.x, lane = tid & 63, wave = tid >> 6;
    const int gtid = blockIdx.x * 512 + tid, NT = gridDim.x * 512;
    float* sc = (float*)smem;
    for (int i = tid; i < 5 * DM; i += 512) { const int r = i >> 11, k = i & 2047; const float v = (r < 4) ? p.in[1][r * DM + k] : p.in[3][k]; sc[i] = v / (1.0f + expf(-v)); }
    __syncthreads();
    float* mod = (float*)(p.ws + OFF_MOD);
    for (int task = gtid; task < 3072 * 42; task += NT) {
        const int cq = task % 3072, ks = task / 3072, k0 = ks * 49, kn = min(49, DM - k0);
        f32x4 a0 = {0.f, 0.f, 0.f, 0.f}, a1 = a0, a2 = a0, a3 = a0, a4 = a0;
        const float* wp = p.in[4] + (size_t)k0 * 12288 + cq * 4;
#pragma unroll 7
        for (int kk = 0; kk < kn; ++kk) { const f32x4 w = *(const f32x4*)(wp + (size_t)kk * 12288); const int k = k0 + kk;
            a0 += sc[k] * w; a1 += sc[DM + k] * w; a2 += sc[2 * DM + k] * w; a3 += sc[3 * DM + k] * w; a4 += sc[4 * DM + k] * w; }
        if (ks == 0) { const f32x4 b = *(const f32x4*)(p.in[5] + cq * 4); a0 += b; a1 += b; a2 += b; a3 += b; a4 += b; }
#pragma unroll
        for (int e = 0; e < 4; ++e) { atomicAdd(mod + 0 * 12288 + cq * 4 + e, a0[e]); atomicAdd(mod + 1 * 12288 + cq * 4 + e, a1[e]); atomicAdd(mod + 2 * 12288 + cq * 4 + e, a2[e]);
            atomicAdd(mod + 3 * 12288 + cq * 4 + e, a3[e]); atomicAdd(mod + 4 * 12288 + cq * 4 + e, a4[e]); }
    }
    __syncthreads();
    float* scr = (float*)smem + wave * (64 * 33);
    bf16_t* WINT = (bf16_t*)((unsigned char*)p.out + OUT_WINT);
    const int gw = blockIdx.x * 8 + wave, NGW = gridDim.x * 8;
    constexpr int I_IN = 32 * (NIN / 32), I_SQ = 32 * 64, I_UP = 32 * (2 * DFF / 32), I_DN = (DFF / 64) * 64;
    constexpr int NITEMS = I_IN + I_SQ + I_UP;
    (void)I_DN;
    for (int it = gw; it < NITEMS; it += NGW) {
        int r = it;
        if (r < I_IN) { const int nblk = NIN / 32, kb = r / nblk, nb = r % nblk, n0 = 32 * nb; const int drow = (n0 >= 64) ? n0 - 64 : 12288 + n0;
            transpose_item(p.in[7], NIN, 64 * kb, n0, WINT, DM, drow, scr, lane); continue; } r -= I_IN;
        if (r < I_SQ) { transpose_item(p.in[17], DM, 64 * (r / 64), 32 * (r % 64), (bf16_t*)(p.ws + OFF_WPO), DM, 32 * (r % 64), scr, lane); continue; } r -= I_SQ;
        { const int nblk = 2 * DFF / 32; transpose_item(p.in[20], 2 * DFF, 64 * (r / nblk), 32 * (r % nblk), (bf16_t*)(p.ws + OFF_WUP), DM, 32 * (r % nblk), scr, lane); }
    }
    for (int i = gtid; i < 2048 * 64; i += NT) { const int row = i >> 6, o8 = (i & 63) * 8; float w[8], s[8], o[8]; load8f(p.in[15] + (size_t)row * 512 + o8, w); load8f(p.in[16] + (row >> 9) * 512 + o8, s);
#pragma unroll
        for (int e = 0; e < 8; ++e) o[e] = w[e] * s[e];
        *(u32x4*)((bf16_t*)(p.ws + OFF_WPW) + (size_t)row * 512 + o8) = pack8(o); }
    { u32x4* z = (u32x4*)(WINT + (size_t)NIN * DM); const u32x4 zero = {0u, 0u, 0u, 0u};
      for (int i = gtid; i < (NINP - NIN) * DM / 8; i += NT) z[i] = zero; }
}

__device__ __forceinline__ void phase_late_weights(const Params& p, unsigned char* smem, int widx, int nw) {
    const int lane = threadIdx.x & 63, wave = threadIdx.x >> 6;
    float* scr = (float*)smem + wave * (64 * 33);
    constexpr int I_SQ = 32 * 64, I_DN = (DFF / 64) * 64;
    for (int it = widx * 8 + wave; it < 2 * I_SQ + I_DN; it += nw * 8) {
        int r = it;
        if (r < I_SQ) { transpose_item(p.in[14], DM, 64 * (r / 64), 32 * (r % 64), (bf16_t*)(p.ws + OFF_WSSD), DM, 32 * (r % 64), scr, lane); continue; } r -= I_SQ;
        if (r < I_SQ) { transpose_item(p.in[18], DM, 64 * (r / 64), 32 * (r % 64), (bf16_t*)(p.ws + OFF_WO), DM, 32 * (r % 64), scr, lane); continue; } r -= I_SQ;
        { transpose_item(p.in[23], DM, 64 * (r / 64), 32 * (r % 64), (bf16_t*)(p.ws + OFF_WDN), DFF, 32 * (r % 64), scr, lane); }
    }
}

__device__ __forceinline__ void phase_modulate(const float* src_lat, const float* src_ctx, int nrows, const float* normw, const float* mod, int shidx, int scidx, bf16_t* dst) {
    const int lane = threadIdx.x & 63, rpb = (nrows + (int)gridDim.x - 1) / (int)gridDim.x, rend = min(nrows, ((int)blockIdx.x + 1) * rpb), gw = blockIdx.x * rpb + (threadIdx.x >> 6), NGW = 8;
    f32x4 v[8], wsc[8], shv[8]; int cur_mi = -1;
    if (gw < rend) { const float* xr = (gw < MLAT) ? src_lat + (size_t)gw * DM : src_ctx + (size_t)(gw - MLAT) * DM;
#pragma unroll
        for (int j = 0; j < 8; ++j) v[j] = *(const f32x4*)(xr + 4 * (lane + 64 * j)); }
    for (int row = gw; row < rend; row += NGW) {
        f32x4 nv[8]; const int nrow = row + NGW;
        if (nrow < rend) { const float* xr = (nrow < MLAT) ? src_lat + (size_t)nrow * DM : src_ctx + (size_t)(nrow - MLAT) * DM;
#pragma unroll
            for (int j = 0; j < 8; ++j) nv[j] = *(const f32x4*)(xr + 4 * (lane + 64 * j)); }
        const int mi = (row < MLAT) ? (row >> 12) : 4;
        if (mi != cur_mi) { cur_mi = mi; const float* mr = mod + (size_t)mi * 12288;
#pragma unroll
            for (int j = 0; j < 8; ++j) { const int col = 4 * (lane + 64 * j); wsc[j] = *(const f32x4*)(normw + col) * (*(const f32x4*)(mr + scidx * DM + col) + 1.0f); shv[j] = *(const f32x4*)(mr + shidx * DM + col); } }
        float s = 0.f;
#pragma unroll
        for (int j = 0; j < 8; ++j) s += (v[j].x * v[j].x + v[j].y * v[j].y) + (v[j].z * v[j].z + v[j].w * v[j].w);
        const float rstd = rsqrtf(wave_sum(s) * (1.0f / DM) + EPS);
#pragma unroll
        for (int j = 0; j < 8; ++j) { const int col = 4 * (lane + 64 * j);
            const f32x4 o = (v[j] * rstd) * wsc[j] + shv[j];
            u32x2 pk; pk.x = pk2(o.x, o.y); pk.y = pk2(o.z, o.w); *(u32x2*)(dst + (size_t)row * DM + col) = pk; }
        if (nrow < rend) {
#pragma unroll
            for (int j = 0; j < 8; ++j) v[j] = nv[j]; }
    }
}

__device__ __forceinline__ void phase_conv_pool(const Params& p, unsigned char* smem) {
    const int tid = threadIdx.x, gtid = blockIdx.x * 512 + tid, NT = gridDim.x * 512;
    const bf16_t* raw = (const bf16_t*)(p.ws + OFF_XBC); const float* cw = p.in[8]; const float* cb = p.in[9];
    bf16_t* xcl = (bf16_t*)p.out; bf16_t* xcc = (bf16_t*)(p.ws + OFF_XC);
    const u32x4 zero = {0u, 0u, 0u, 0u};
    {
        const int col = tid * 8, tpb = (MLAT + (int)gridDim.x - 1) / (int)gridDim.x, t0 = blockIdx.x * tpb, t1 = min(t0 + tpb, MLAT);
        float w0[8], w1[8], w2[8], bb[8]; load8f(cw + col, w0); load8f(cw + 4096 + col, w1); load8f(cw + 8192 + col, w2); load8f(cb + col, bb);
        if (t0 < t1) {
            const bf16_t* src = raw + (size_t)t0 * 4096 + col; bf16_t* dst = xcl + (size_t)t0 * 4096 + col;
            float x0[8], x1[8];
            unpack8(((t0 & (SEQ - 1)) != 0) ? *(const u32x4*)(src - 4096) : zero, x0); unpack8(*(const u32x4*)src, x1);
#pragma unroll 4
            for (int t = t0; t < t1; ++t) {
                const u32x4 r2 = (((t + 1) & (SEQ - 1)) != 0) ? __builtin_nontemporal_load((const u32x4*)(src + 4096)) : zero;
                float x2[8], o[8]; unpack8(r2, x2);
#pragma unroll
                for (int e = 0; e < 8; ++e) o[e] = siluf_(x0[e] * w0[e] + bb[e] + x1[e] * w1[e] + x2[e] * w2[e]);
                *(u32x4*)dst = pack8(o);
#pragma unroll
                for (int e = 0; e < 8; ++e) { x0[e] = x1[e]; x1[e] = x2[e]; }
                src += 4096; dst += 4096;
            }
        }
    }
    for (int idx = gtid; idx < MCTX * 384; idx += NT) {
        const int t = idx / 384, col = (idx % 384) * 8, tl = t & (CTXL - 1); const bf16_t* src = raw + (size_t)(MLAT + t) * 4096 + col; bf16_t* dst = xcc + (size_t)t * 4096 + col;
        const u32x4 r1 = *(const u32x4*)src; const u32x4 r0 = (tl > 0) ? *(const u32x4*)(src - 4096) : zero; const u32x4 r2 = (tl < CTXL - 1) ? *(const u32x4*)(src + 4096) : zero;
        float x0[8], x1[8], x2[8], w0[8], w1[8], w2[8], b[8], o[8];
        unpack8(r0, x0); unpack8(r1, x1); unpack8(r2, x2); load8f(cw + col, w0); load8f(cw + 4096 + col, w1); load8f(cw + 8192 + col, w2); load8f(cb + col, b);
#pragma unroll
        for (int e = 0; e < 8; ++e) o[e] = siluf_(x0[e] * w0[e] + b[e] + x1[e] * w1[e] + x2[e] * w2[e]);
        *(u32x4*)dst = pack8(o);
    }
    const bf16_t* V = (const bf16_t*)(p.ws + OFF_V); bf16_t* P = (bf16_t*)(p.ws + OFF_P);
    PG8_LAS unsigned char* L = (PG8_LAS unsigned char*)smem;
    for (int it = blockIdx.x; it < (MLAT / 64) * 4; it += gridDim.x) {
        const int gr = it >> 2, g = it & 3, hw = 1 << g;
        const bf16_t* base = V + (size_t)gr * 64 * DM + g * 512;
        __syncthreads();
#pragma unroll
        for (int j = 0; j < 8; ++j) { const int piece = tid + 512 * j, row = piece >> 6, pc = piece & 63; *(PG8_LAS u32x4*)(L + row * 1024 + pc * 16) = *(const u32x4*)(base + (size_t)row * DM + pc * 8); }
        __syncthreads();
        const int cvv = tid & 63, tq = tid >> 6;
        float s[8];
#pragma unroll
        for (int e = 0; e < 8; ++e) s[e] = 0.f;
        for (int jj = max(tq * 8 - hw, 0); jj < min(tq * 8 + hw, 64); ++jj) { float x[8]; unpack8(*(const PG8_LAS u32x4*)(L + jj * 1024 + cvv * 16), x);
#pragma unroll
            for (int e = 0; e < 8; ++e) s[e] += x[e]; }
        for (int i = 0; i < 8; ++i) { const int tc = tq * 8 + i, lo = max(tc - hw, 0), hi = min(tc + hw, 64);
            float me[8], o[8];
            if (i > 0) {
                const int ad = tc - 1 + hw, sb = tc - 1 - hw;
                if (ad < 64) { float x[8]; unpack8(*(const PG8_LAS u32x4*)(L + ad * 1024 + cvv * 16), x);
#pragma unroll
                    for (int e = 0; e < 8; ++e) s[e] += x[e]; }
                if (sb >= 0) { float x[8]; unpack8(*(const PG8_LAS u32x4*)(L + sb * 1024 + cvv * 16), x);
#pragma unroll
                    for (int e = 0; e < 8; ++e) s[e] -= x[e]; }
            }
            unpack8(*(const PG8_LAS u32x4*)(L + tc * 1024 + cvv * 16), me);
            const float inv = 1.0f / (float)(hi - lo);
#pragma unroll
            for (int e = 0; e < 8; ++e) o[e] = s[e] * inv - me[e];
            *(u32x4*)(P + (size_t)(gr * 64 + tc) * DM + g * 512 + cvv * 8) = pack8(o); }
    }
}

__device__ __forceinline__ void phase_ssd_scan(const Params& p, unsigned char* smem) {
    const int tid = threadIdx.x, lane = tid & 63, wave = tid >> 6;
    float* sX = (float*)smem;
    float* sB = sX + 32 * 64;
    float* sC = sB + 32 * 128;
    float* sY = sC + 32 * 128;
    float* sdt = sY + 8 * 32 * 64;
    const bf16_t* xcl = (const bf16_t*)p.out; const bf16_t* xcc = (const bf16_t*)(p.ws + OFF_XC); const float* DT = (const float*)(p.ws + OFF_DT);
    for (int item = blockIdx.x; item < 256; item += gridDim.x) {
        const int xcd = item & 7, slot = item >> 3, gid = xcd * 4 + (slot >> 3), mem = slot & 7;
        const int b = gid >> 3, g = gid & 7, dir = mem >> 2, h = g * 4 + (mem & 3);
        const float Ah = -expf(p.in[11][dir * 32 + h]), dsk = p.in[12][dir * 32 + h];
        bf16_t* Y = (bf16_t*)(p.ws + (dir ? OFF_YB : OFF_YF));
        float hs[16];
#pragma unroll
        for (int j = 0; j < 16; ++j) hs[j] = 0.f;
        for (int ck = 0; ck < (CTXL + SEQ) / 32; ++ck) {
            const bool isctx = ck < CTXL / 32;
            __syncthreads();
            {   const int i = tid >> 4, q = tid & 15;
                const int s = ck * 32 + i;
                int tok; const bf16_t* rowp; size_t drow;
                if (isctx) { tok = dir ? (CTXL - 1 - s) : s; rowp = xcc + (size_t)(b * CTXL + tok) * 4096; drow = (size_t)(MLAT + b * CTXL + tok); }
                else { const int s2 = s - CTXL; tok = dir ? (SEQ - 1 - s2) : s2; rowp = xcl + (size_t)(b * SEQ + tok) * 4096; drow = (size_t)(b * SEQ + tok); }
                { const u32x2 xv = *(const u32x2*)(rowp + h * 64 + q * 4); float* d = sX + i * 64 + q * 4; d[0] = bflo(xv.x); d[1] = bfhi(xv.x); d[2] = bflo(xv.y); d[3] = bfhi(xv.y); }
                { float o[8]; unpack8(*(const u32x4*)(rowp + 2048 + g * 128 + q * 8), o); float* d = sB + i * 128 + q * 8;
#pragma unroll
                  for (int e = 0; e < 8; ++e) d[e] = o[e]; }
                if (!isctx) { float o[8]; unpack8(*(const u32x4*)(rowp + 3072 + g * 128 + q * 8), o); float* d = sC + i * 128 + q * 8;
#pragma unroll
                  for (int e = 0; e < 8; ++e) d[e] = o[e]; }
                if (q == 0) { const float dt = DT[drow * 64 + dir * 32 + h]; sdt[i] = dt; sdt[32 + i] = expf(dt * Ah); }
            }
            __syncthreads();
            for (int i = 0; i < 32; ++i) {
                const float dt = sdt[i], dA = sdt[32 + i], xd = sX[i * 64 + lane] * dt;
                const float* bp = sB + i * 128 + wave * 16; const float* cp = sC + i * 128 + wave * 16;
                float yp = 0.f;
#pragma unroll
                for (int j = 0; j < 16; ++j) { hs[j] = hs[j] * dA + xd * bp[j]; yp += cp[j] * hs[j]; }
                sY[(wave * 32 + i) * 64 + lane] = yp;
            }
            __syncthreads();
            if (!isctx) {
                const int i = tid >> 4, q = tid & 15, s2 = ck * 32 + i - CTXL, tok = dir ? (SEQ - 1 - s2) : s2;
                float o[4];
#pragma unroll
                for (int e = 0; e < 4; ++e) { const int pp = q * 4 + e; float a = dsk * sX[i * 64 + pp];
#pragma unroll
                    for (int w = 0; w < 8; ++w) a += sY[(w * 32 + i) * 64 + pp];
                    o[e] = a; }
                u32x2 pk; pk.x = pk2(o[0], o[1]); pk.y = pk2(o[2], o[3]);
                *(u32x2*)(Y + (size_t)(b * SEQ + tok) * DM + h * 64 + q * 4) = pk;
            }
        }
    }
}


constexpr int SS_LD = 272;
constexpr int SS_C = 0, SS_B = 34816, SS_BT = 69632, SS_XT = 104448, SS_HB = 121856, SS_CS = 139264, SS_DT = 139776, SS_HB2 = 140288, SS_END = 157696;
__device__ __forceinline__ void phase_ssd_mfma(const Params& p, unsigned char* smem) {
    using pg8::bf16x8;
    const int tid = threadIdx.x, lane = tid & 63, wave = __builtin_amdgcn_readfirstlane(tid >> 6), fr = lane & 15, fq = lane >> 4;
    PG8_LAS unsigned char* L = (PG8_LAS unsigned char*)smem;
    PG8_LAS float* scs = (PG8_LAS float*)(L + SS_CS); PG8_LAS float* sdt = (PG8_LAS float*)(L + SS_DT);
    const bf16_t* xcl = (const bf16_t*)p.out; const bf16_t* xcc = (const bf16_t*)(p.ws + OFF_XC); const float* DT = (const float*)(p.ws + OFF_DT);
#define SSD_ROW(s_, rowp_, drow_) do { if (isctx) { const int tk_ = dir ? (CTXL - 1 - (sbase + (s_))) : (sbase + (s_)); const int gr_ = b * CTXL + tk_; rowp_ = xcc + (size_t)gr_ * 4096; drow_ = MLAT + gr_; } \
        else { const int tk_ = dir ? (SEQ - 1 - (sbase + (s_))) : (sbase + (s_)); const int gr_ = b * SEQ + tk_; rowp_ = xcl + (size_t)gr_ * 4096; drow_ = gr_; } } while (0)
#define SSD_FRAG(off_, row_, ks_) (*(const PG8_LAS bf16x8*)(L + (off_) + (row_) * SS_LD + (ks_) * 64 + fq * 16))
    for (int item = blockIdx.x; item < 256; item += gridDim.x) {
        const int xcd = item & 7, slot = item >> 3, gid = xcd * 4 + (slot >> 3), mem = slot & 7;
        const int b = gid >> 3, g = gid & 7, dir = mem >> 2, h = g * 4 + (mem & 3);
        const float Ah = -expf(p.in[11][dir * 32 + h]), dsk = p.in[12][dir * 32 + h];
        bf16_t* Y = (bf16_t*)(p.ws + (dir ? OFF_YB : OFF_YF));
        f32x4 H[4];
#pragma unroll
        for (int j = 0; j < 4; ++j) H[j] = (f32x4){0.f, 0.f, 0.f, 0.f};
        const int hi_half = wave & 1, sm = lane + 64 * hi_half, q4 = wave >> 1;
        float dt_lo, dt_hi; u32x4 xv[2], bv[4], cv[4];
#define SSD_LOAD(ckk_) do { const int ck_ = (ckk_); const bool isctx = ck_ < CTXL / 128; const int sbase = isctx ? ck_ * 128 : (ck_ - CTXL / 128) * 128; \
            const bf16_t *rl_, *rh_; int dl_, dh_; SSD_ROW(lane, rl_, dl_); SSD_ROW(lane + 64, rh_, dh_); \
            dt_lo = DT[(size_t)dl_ * 64 + dir * 32 + h]; dt_hi = DT[(size_t)dh_ * 64 + dir * 32 + h]; const bf16_t* rp_ = hi_half ? rh_ : rl_; \
            _Pragma("unroll") for (int j_ = 0; j_ < 2; ++j_) xv[j_] = *(const u32x4*)(rp_ + h * 64 + 8 * (q4 + 4 * j_)); \
            _Pragma("unroll") for (int j_ = 0; j_ < 4; ++j_) bv[j_] = *(const u32x4*)(rp_ + 2048 + g * 128 + 8 * (q4 + 4 * j_)); \
            if (!isctx) { _Pragma("unroll") for (int j_ = 0; j_ < 4; ++j_) { const bf16_t* rc_; int dc_; SSD_ROW((tid >> 4) + 32 * j_, rc_, dc_); (void)dc_; cv[j_] = *(const u32x4*)(rc_ + 3072 + g * 128 + (tid & 15) * 8); } } } while (0)
#define LBAR() do { asm volatile("s_waitcnt lgkmcnt(0)" ::: "memory"); __builtin_amdgcn_s_barrier(); asm volatile("" ::: "memory"); } while (0)
        SSD_LOAD(0);
        for (int ck = 0; ck < (CTXL + SEQ) / 128; ++ck) {
            const bool isctx = ck < CTXL / 128;
            const int sbase = isctx ? ck * 128 : (ck - CTXL / 128) * 128;
            LBAR();
            float c_lo = dt_lo * Ah, c_hi = dt_hi * Ah;
            c_lo = wave_incl_scan(c_lo); c_hi = wave_incl_scan(c_hi);
            c_hi += __int_as_float(__builtin_amdgcn_readlane(__float_as_int(c_lo), 63));
            const float c_last = __int_as_float(__builtin_amdgcn_readlane(__float_as_int(c_hi), 63));
            if (wave == 0) { scs[lane] = c_lo; scs[lane + 64] = c_hi; sdt[lane] = dt_lo; sdt[lane + 64] = dt_hi; }
            const float wsc = (hi_half ? dt_hi : dt_lo) * __expf(c_last - (hi_half ? c_hi : c_lo));
#pragma unroll
            for (int j = 0; j < 2; ++j) { const int p0 = 8 * (q4 + 4 * j); const u32x4 v = xv[j];
                PG8_LAS unsigned char* d = L + SS_XT + p0 * SS_LD + sm * 2;
                *(PG8_LAS unsigned short*)(d + 0 * SS_LD) = (unsigned short)(v.x & 0xffffu); *(PG8_LAS unsigned short*)(d + 1 * SS_LD) = (unsigned short)(v.x >> 16);
                *(PG8_LAS unsigned short*)(d + 2 * SS_LD) = (unsigned short)(v.y & 0xffffu); *(PG8_LAS unsigned short*)(d + 3 * SS_LD) = (unsigned short)(v.y >> 16);
                *(PG8_LAS unsigned short*)(d + 4 * SS_LD) = (unsigned short)(v.z & 0xffffu); *(PG8_LAS unsigned short*)(d + 5 * SS_LD) = (unsigned short)(v.z >> 16);
                *(PG8_LAS unsigned short*)(d + 6 * SS_LD) = (unsigned short)(v.w & 0xffffu); *(PG8_LAS unsigned short*)(d + 7 * SS_LD) = (unsigned short)(v.w >> 16); }
#pragma unroll
            for (int j = 0; j < 4; ++j) { const int n0 = 8 * (q4 + 4 * j); const u32x4 v = bv[j];
                if (!isctx) *(PG8_LAS u32x4*)(L + SS_B + sm * SS_LD + n0 * 2) = v;
                float f[8]; unpack8(v, f);
                PG8_LAS unsigned char* d = L + SS_BT + n0 * SS_LD + sm * 2;
#pragma unroll
                for (int e = 0; e < 8; e += 2) { const unsigned w2 = pk2(f[e] * wsc, f[e + 1] * wsc);
                    *(PG8_LAS unsigned short*)(d + e * SS_LD) = (unsigned short)(w2 & 0xffffu); *(PG8_LAS unsigned short*)(d + (e + 1) * SS_LD) = (unsigned short)(w2 >> 16); } }
            if (!isctx) {
#pragma unroll
                for (int j = 0; j < 4; ++j) *(PG8_LAS u32x4*)(L + SS_C + ((tid >> 4) + 32 * j) * SS_LD + (tid & 15) * 16) = cv[j];
            }
            if (ck + 1 < (CTXL + SEQ) / 128) SSD_LOAD(ck + 1);
            LBAR();
            f32x4 aY[4];
#define SB0() __builtin_amdgcn_sched_barrier(0)
            const int hb_rd = (ck & 1) ? SS_HB2 : SS_HB, hb_wr = (ck & 1) ? SS_HB : SS_HB2;
            const int l = 16 * wave + fr;
            if (!isctx) {
                bf16x8 cf[4];
#pragma unroll
                for (int ks = 0; ks < 4; ++ks) cf[ks] = SSD_FRAG(SS_C, l, ks);
#pragma unroll
                for (int ph = 0; ph < 2; ++ph) { bf16x8 hb[8];
#pragma unroll
                    for (int q = 0; q < 8; ++q) hb[q] = SSD_FRAG(hb_rd, 16 * (2 * ph + (q >> 2)) + fr, q & 3);
                    SB0();
                    f32x4 a0 = {0.f, 0.f, 0.f, 0.f}, a1 = a0;
#pragma unroll
                    for (int ks = 0; ks < 4; ++ks) { a0 = __builtin_amdgcn_mfma_f32_16x16x32_bf16(hb[ks], cf[ks], a0, 0, 0, 0); a1 = __builtin_amdgcn_mfma_f32_16x16x32_bf16(hb[4 + ks], cf[ks], a1, 0, 0, 0); }
                    aY[2 * ph] = a0; aY[2 * ph + 1] = a1;
                    SB0(); }
                const float csl = scs[l];
#pragma unroll
                for (int sp = 0; sp < 4; ++sp) {
                    if (2 * sp <= wave) {
                        bf16x8 bq[4], br[4];
#pragma unroll
                        for (int q = 0; q < 4; ++q) bq[q] = SSD_FRAG(SS_B, 16 * (2 * sp) + fr, q);
#pragma unroll
                        for (int q = 0; q < 4; ++q) br[q] = SSD_FRAG(SS_B, 16 * (2 * sp + 1) + fr, q);
                        const int s0 = 32 * sp + 4 * fq;
                        const f32x4 csA = *(const PG8_LAS f32x4*)(scs + s0), dtA = *(const PG8_LAS f32x4*)(sdt + s0), csB = *(const PG8_LAS f32x4*)(scs + s0 + 16), dtB = *(const PG8_LAS f32x4*)(sdt + s0 + 16);
                        SB0();
                        f32x4 a0 = {0.f, 0.f, 0.f, 0.f}, a1 = a0;
#pragma unroll
                        for (int ks = 0; ks < 4; ++ks) a0 = __builtin_amdgcn_mfma_f32_16x16x32_bf16(bq[ks], cf[ks], a0, 0, 0, 0);
#pragma unroll
                        for (int ks = 0; ks < 4; ++ks) a1 = __builtin_amdgcn_mfma_f32_16x16x32_bf16(br[ks], cf[ks], a1, 0, 0, 0);
                        float m0[4], m1[4];
#pragma unroll
                        for (int r = 0; r < 4; ++r) { const float e0 = __expf(fminf(csl - csA[r], 0.f)) * dtA[r], e1 = __expf(fminf(csl - csB[r], 0.f)) * dtB[r];
                            m0[r] = (s0 + r <= l) ? a0[r] * e0 : 0.f; m1[r] = (s0 + 16 + r <= l) ? a1[r] * e1 : 0.f; }
                        u32x2 w0, w1; w0.x = pk2(m0[0], m0[1]); w0.y = pk2(m0[2], m0[3]); w1.x = pk2(m1[0], m1[1]); w1.y = pk2(m1[2], m1[3]);
                        *(PG8_LAS u32x2*)(L + SS_C + l * SS_LD + s0 * 2) = w0; *(PG8_LAS u32x2*)(L + SS_C + l * SS_LD + (s0 + 16) * 2) = w1;
                        SB0();
                    }
                }
            }
            asm volatile("" ::: "memory");
            {
                const float dec = __expf(c_last); bf16x8 af[4];
#pragma unroll
                for (int ks = 0; ks < 4; ++ks) af[ks] = SSD_FRAG(SS_BT, l, ks);
#pragma unroll
                for (int ph = 0; ph < 2; ++ph) { bf16x8 xt[8];
#pragma unroll
                    for (int q = 0; q < 8; ++q) xt[q] = SSD_FRAG(SS_XT, 16 * (2 * ph + (q >> 2)) + fr, q & 3);
                    SB0();
                    f32x4 a0 = H[2 * ph] * dec, a1 = H[2 * ph + 1] * dec;
#pragma unroll
                    for (int ks = 0; ks < 4; ++ks) { a0 = __builtin_amdgcn_mfma_f32_16x16x32_bf16(af[ks], xt[ks], a0, 0, 0, 0); a1 = __builtin_amdgcn_mfma_f32_16x16x32_bf16(af[ks], xt[4 + ks], a1, 0, 0, 0); }
                    H[2 * ph] = a0; H[2 * ph + 1] = a1;
                    SB0(); }
                asm volatile("s_nop 15\n\ts_nop 7" : "+v"(H[0]), "+v"(H[1]), "+v"(H[2]), "+v"(H[3]));
#pragma unroll
                for (int pt = 0; pt < 4; ++pt) { u32x2 w; w.x = pk2(H[pt][0], H[pt][1]); w.y = pk2(H[pt][2], H[pt][3]); *(PG8_LAS u32x2*)(L + hb_wr + (16 * pt + fr) * SS_LD + (16 * wave + 4 * fq) * 2) = w; }
            }
            if (!isctx) {
                const float el = __expf(scs[l]);
                const int nks = ((16 * wave + 15) >> 5) + 1;
                const int tokl = dir ? (SEQ - 1 - (sbase + l)) : (sbase + l);
                bf16x8 mf[4];
#pragma unroll
                for (int ks = 0; ks < 4; ++ks) mf[ks] = SSD_FRAG(SS_C, l, (ks < nks) ? ks : 0);
#pragma unroll
                for (int ph = 0; ph < 2; ++ph) { bf16x8 xt[8]; unsigned xb[8];
#pragma unroll
                    for (int q = 0; q < 8; ++q) xt[q] = SSD_FRAG(SS_XT, 16 * (2 * ph + (q >> 2)) + fr, ((q & 3) < nks) ? (q & 3) : 0);
#pragma unroll
                    for (int q = 0; q < 8; ++q) xb[q] = *(const PG8_LAS unsigned short*)(L + SS_XT + (16 * (2 * ph + (q >> 2)) + 4 * fq + (q & 3)) * SS_LD + l * 2);
                    SB0();
#pragma unroll
                    for (int hh = 0; hh < 2; ++hh) { const int pt = 2 * ph + hh; f32x4 a = aY[pt] * el;
#pragma unroll
                        for (int ks = 0; ks < 4; ++ks) if (ks < nks) a = __builtin_amdgcn_mfma_f32_16x16x32_bf16(xt[hh * 4 + ks], mf[ks], a, 0, 0, 0);
#pragma unroll
                        for (int r = 0; r < 4; ++r) a[r] += dsk * __uint_as_float(xb[hh * 4 + r] << 16);
                        u32x2 w; w.x = pk2(a[0], a[1]); w.y = pk2(a[2], a[3]);
                        *(u32x2*)(Y + (size_t)(b * SEQ + tokl) * DM + h * 64 + 16 * pt + 4 * fq) = w; }
                    SB0(); }
            }
        }
        LBAR();
    }
#undef SSD_ROW
#undef SSD_FRAG
#undef SSD_LOAD
#undef LBAR
#undef SB0
}

__device__ __forceinline__ void phase_gate_norm(const Params& p) {
    const int lane = threadIdx.x & 63, rpb = (MLAT + (int)gridDim.x - 1) / (int)gridDim.x, rend = min(MLAT, ((int)blockIdx.x + 1) * rpb), gw = blockIdx.x * rpb + (threadIdx.x >> 6), NGW = 8;
    const bf16_t* YF = (const bf16_t*)(p.ws + OFF_YF); const bf16_t* YB = (const bf16_t*)(p.ws + OFF_YB); bf16_t* Z = (bf16_t*)(p.ws + OFF_Z); const float* nw = p.in[13];
    u32x4 ra[4], rb[4], rz[4];
    if (gw < rend) {
#pragma unroll
        for (int j = 0; j < 4; ++j) { const size_t off = (size_t)gw * DM + j * 512 + 8 * lane; ra[j] = __builtin_nontemporal_load((const u32x4*)(YF + off)); rb[j] = __builtin_nontemporal_load((const u32x4*)(YB + off)); rz[j] = __builtin_nontemporal_load((const u32x4*)(Z + off)); } }
    for (int row = gw; row < rend; row += NGW) {
        u32x4 na[4], nb[4], nz[4]; const int nrow = row + NGW;
        if (nrow < rend) {
#pragma unroll
            for (int j = 0; j < 4; ++j) { const size_t off = (size_t)nrow * DM + j * 512 + 8 * lane; na[j] = __builtin_nontemporal_load((const u32x4*)(YF + off)); nb[j] = __builtin_nontemporal_load((const u32x4*)(YB + off)); nz[j] = __builtin_nontemporal_load((const u32x4*)(Z + off)); } }
#pragma unroll
        for (int j = 0; j < 4; ++j) { const int col = j * 512 + 8 * lane; const size_t off = (size_t)row * DM + col;
            float a[8], b[8], z[8], w[8], o[8]; unpack8(ra[j], a); unpack8(rb[j], b); unpack8(rz[j], z); load8f(nw + col, w);
            float ss = 0.f;
#pragma unroll
            for (int e = 0; e < 8; ++e) { o[e] = (a[e] + b[e]) * siluf_(z[e]); ss += o[e] * o[e]; }
#pragma unroll
            for (int m = 1; m < 32; m <<= 1) ss += __shfl_xor(ss, m);
            const float rstd = rsqrtf(ss * (1.0f / 256.0f) + EPS);
#pragma unroll
            for (int e = 0; e < 8; ++e) o[e] = o[e] * rstd * w[e];
            *(u32x4*)(Z + off) = pack8(o); }
        if (nrow < rend) {
#pragma unroll
            for (int j = 0; j < 4; ++j) { ra[j] = na[j]; rb[j] = nb[j]; rz[j] = nz[j]; } }
    }
}

__device__ __forceinline__ void phase_ffn_act(const Params& p) {
    const int gtid = blockIdx.x * 512 + threadIdx.x, NT = gridDim.x * 512;
    bf16_t* A = (bf16_t*)(p.ws + OFF_UPA); const bf16_t* G = (const bf16_t*)(p.ws + OFF_UPG); const float* fw = p.in[21]; const float* fb = p.in[22];
    const u32x4 zero = {0u, 0u, 0u, 0u};
    constexpr int NCV = DFF / 8, NHL = NBATCH * 64 * 2;
    for (int task = gtid; task < NCV * NHL; task += NT) {
        const int cvi = task % NCV, hl = task / NCV, col = cvi * 8, bq = hl >> 7, gc = (hl >> 1) & 63, r0 = (hl & 1) * 32;
        float w0[8], w1[8], w2[8], b[8]; load8f(fw + col, w0); load8f(fw + DFF + col, w1); load8f(fw + 2 * DFF + col, w2); load8f(fb + col, b);
        const size_t rstride = (size_t)64 * DFF;
        size_t off = ((size_t)(bq * SEQ + r0 * 64 + gc)) * DFF + col;
        float x0[8], x1[8];
        unpack8((r0 > 0) ? *(const u32x4*)(G + off - rstride) : zero, x0); unpack8(*(const u32x4*)(G + off), x1);
#pragma unroll 4
        for (int r = r0; r < r0 + 32; ++r) {
            const u32x4 g2 = (r < 63) ? __builtin_nontemporal_load((const u32x4*)(G + off + rstride)) : zero;
            float x2[8], a[8], o[8];
            unpack8(g2, x2); unpack8(__builtin_nontemporal_load((const u32x4*)(A + off)), a);
#pragma unroll
            for (int e = 0; e < 8; e += 2) { f32x2 gv; gv.x = x0[e] * w0[e] + b[e] + x1[e] * w1[e] + x2[e] * w2[e]; gv.y = x0[e + 1] * w0[e + 1] + b[e + 1] + x1[e + 1] * w1[e + 1] + x2[e + 1] * w2[e + 1];
                const f32x2 ge = gelu_pk(gv); o[e] = ge.x * a[e]; o[e + 1] = ge.y * a[e + 1]; }
            *(u32x4*)(A + off) = pack8(o);
#pragma unroll
            for (int e = 0; e < 8; ++e) { x0[e] = x1[e]; x1[e] = x2[e]; }
            off += rstride;
        }
    }
}

__device__ __forceinline__ void phase_final_norm(const Params& p) {
    const int lane = threadIdx.x & 63, rpb = (MLAT + (int)gridDim.x - 1) / (int)gridDim.x, rend = min(MLAT, ((int)blockIdx.x + 1) * rpb), gw = blockIdx.x * rpb + (threadIdx.x >> 6), NGW = 8; const float* fw = p.in[24];
    const unsigned short* x2 = (const unsigned short*)(p.ws + OFF_UPG);
    u32x4 v[4]; f32x4 fwa[4], fwb[4];
#pragma unroll
    for (int j = 0; j < 4; ++j) { fwa[j] = *(const f32x4*)(fw + 8 * (lane + 64 * j)); fwb[j] = *(const f32x4*)(fw + 8 * (lane + 64 * j) + 4); }
    if (gw < rend) {
#pragma unroll
        for (int j = 0; j < 4; ++j) v[j] = __builtin_nontemporal_load((const u32x4*)(x2 + (size_t)gw * DM + 8 * (lane + 64 * j))); }
    for (int row = gw; row < rend; row += NGW) {
        u32x4 nv[4]; const int nrow = row + NGW;
        if (nrow < rend) {
#pragma unroll
            for (int j = 0; j < 4; ++j) nv[j] = __builtin_nontemporal_load((const u32x4*)(x2 + (size_t)nrow * DM + 8 * (lane + 64 * j))); }
        float* xr = p.out + (size_t)row * DM; float s = 0.f; f32x4 a[4], b[4];
#pragma unroll
        for (int j = 0; j < 4; ++j) { unpackh44(v[j], a[j], b[j]); s += (a[j].x * a[j].x + a[j].y * a[j].y) + (a[j].z * a[j].z + a[j].w * a[j].w) + (b[j].x * b[j].x + b[j].y * b[j].y) + (b[j].z * b[j].z + b[j].w * b[j].w); }
        const float rstd = rsqrtf(wave_sum(s) * (1.0f / DM) + EPS);
#pragma unroll
        for (int j = 0; j < 4; ++j) { const int col = 8 * (lane + 64 * j); *(f32x4*)(xr + col) = a[j] * rstd * fwa[j]; *(f32x4*)(xr + col + 4) = b[j] * rstd * fwb[j]; }
        if (nrow < rend) {
#pragma unroll
            for (int j = 0; j < 4; ++j) v[j] = nv[j]; }
    }
}

#define XB_TMO      128
#define XB_XCNT(j)  (256  + 64 * (j))
#define XB_XSUB(j)  (1280 + 64 * (j))
#define XB_XGEN(j)  (2304 + 64 * (j))
#define XB_TOP      3328
#define XB_TOPGEN   3392
#define XCD_BAR_WORDS 3456
#define XB_SPIN_CAP (1u << 20)
__device__ __forceinline__ unsigned xb_ld(unsigned* p)              { return __hip_atomic_load(p, __ATOMIC_RELAXED, __HIP_MEMORY_SCOPE_AGENT); }
__device__ __forceinline__ unsigned xb_add(unsigned* p, unsigned v) { return __hip_atomic_fetch_add(p, v, __ATOMIC_RELAXED, __HIP_MEMORY_SCOPE_AGENT); }
__device__ __forceinline__ unsigned xb_xcc_id() { return (unsigned)__builtin_amdgcn_s_getreg((3 << 11) | 20) & 0xFu; }
#define XB_SPIN(cond, bar) do { unsigned _sp = 0; while (cond) { __builtin_amdgcn_s_sleep(1); \
    if ((++_sp & 255u) == 0u) { if (xb_ld(&(bar)[XB_TMO])) break; if (_sp > XB_SPIN_CAP) { atomicAdd(&(bar)[XB_TMO], 1u); break; } } } } while (0)
struct XcdBarrier { unsigned* bar; unsigned x; volatile PG8_LAS unsigned* st; };
__device__ __forceinline__ XcdBarrier xcd_barrier_post(unsigned* bar, volatile PG8_LAS unsigned* st) {
    XcdBarrier b; b.bar = bar; b.x = xb_xcc_id(); b.st = st;
    if (threadIdx.x == 0) (void)xb_add(&bar[XB_XCNT(b.x)], 1u);
    return b;
}
__device__ __forceinline__ void xcd_barrier_complete(unsigned* bar, unsigned x, unsigned& nloc, unsigned& nx) {
    const unsigned G = gridDim.x * gridDim.y * gridDim.z;
    unsigned sum, cnt, mine, sp = 0u;
    for (;;) {
        sum = 0u; cnt = 0u; mine = 0u;
#pragma unroll
        for (unsigned j = 0; j < 16; ++j) { const unsigned c = xb_ld(&bar[XB_XCNT(j)]); sum += c; cnt += (c > 0u) ? 1u : 0u; mine = (j == x) ? c : mine; }
        if (sum == G) break;
        __builtin_amdgcn_s_sleep(1);
        if ((++sp & 255u) == 0u) { if (xb_ld(&bar[XB_TMO])) break; if (sp > XB_SPIN_CAP) { atomicAdd(&bar[XB_TMO], 1u); break; } }
    }
    nloc = mine > 0u ? mine : 1u; nx = cnt > 0u ? cnt : 1u;
}
__device__ __forceinline__ void xcd_barrier(const XcdBarrier& b) {
    asm volatile("s_waitcnt vmcnt(0)" ::: "memory");
    __syncthreads();
    if (threadIdx.x == 0) {
        unsigned* bar = b.bar;
        __builtin_amdgcn_s_waitcnt(0);
        unsigned nloc = b.st[0], nx = b.st[1];
        if (nloc == 0u) { xcd_barrier_complete(bar, b.x, nloc, nx); b.st[0] = nloc; b.st[1] = nx; }
        const unsigned old = xb_add(&bar[XB_XSUB(b.x)], 1u);
        const unsigned gen = old / nloc;
        if (old + 1u == (gen + 1u) * nloc) {
            __builtin_amdgcn_fence(__ATOMIC_RELEASE, "agent");
            asm volatile("s_waitcnt vmcnt(0)" ::: "memory");
            const unsigned og = xb_add(&bar[XB_TOP], 1u);
            const unsigned tg = og / nx;
            if (og + 1u == (tg + 1u) * nx) xb_add(&bar[XB_TOPGEN], 1u);
            else XB_SPIN(xb_ld(&bar[XB_TOPGEN]) == tg, bar);
            __builtin_amdgcn_fence(__ATOMIC_ACQUIRE, "agent");
            xb_add(&bar[XB_XGEN(b.x)], 1u);
            asm volatile("s_waitcnt vmcnt(0)" ::: "memory");
        } else {
            XB_SPIN(xb_ld(&bar[XB_XGEN(b.x)]) == gen, bar);
            __builtin_amdgcn_fence(__ATOMIC_ACQUIRE, "agent");
            asm volatile("s_waitcnt vmcnt(0)" ::: "memory");
        }
    }
    __syncthreads();
}

constexpr int NPHASES = 14;


__global__ __launch_bounds__(512, 2) void mk_fwd(Params p) {
    extern __shared__ __attribute__((aligned(16))) unsigned char smem[];
    PG8_LAS unsigned char* lds = (PG8_LAS unsigned char*)smem;
    const int lo = p.ph_lo, hi = p.ph_hi;
    const int G = (int)gridDim.x, c = (int)blockIdx.x;
    const float* mod = (const float*)(p.ws + OFF_MOD);
#define IN(k) (lo <= (k) && (k) < hi)
    volatile PG8_LAS unsigned* xst = (volatile PG8_LAS unsigned*)(lds + 157696);
    if (threadIdx.x == 0) { xst[0] = 0u; xst[1] = 0u; }
    __syncthreads();
    const XcdBarrier xb = xcd_barrier_post((unsigned*)(p.ws + OFF_BAR), xst);
#define SEAM(k) do { if (IN(k) && IN((k) + 1)) xcd_barrier(xb); } while (0)

    if (IN(0)) { phase_prologue(p, smem); } SEAM(0);
    if (IN(1)) {
        {
            pg8::Gemm g{(const bf16_t*)(p.ws + OFF_WPO), (const bf16_t*)(p.ws + OFF_WPW), DM, 512, 512, 2, nullptr, nullptr};
            pg8::Order S; S.init(DM / 256, DM / 256, G, c);
            EpiPlain E{(bf16_t*)(p.ws + OFF_WFOLD)};
            pg8::gemm_phase(lds, g, S, E);
        }
        phase_modulate(p.in[0], p.in[2], MTOT, p.in[6], mod, 0, 1, (bf16_t*)((unsigned char*)p.out + OUT_HN));
        {
            const int lane = threadIdx.x & 63, gw = c * 8 + (threadIdx.x >> 6), NGW = G * 8; const bf16_t* WU = (const bf16_t*)(p.ws + OFF_WUP); float* B2 = (float*)(p.ws + OFF_BIAS2);
            for (int n = gw; n < 2 * DFF; n += NGW) { float s0 = 0.f, s1 = 0.f, s2 = 0.f, s3 = 0.f;
#pragma unroll
                for (int j = 0; j < 4; ++j) { const int k = j * 512 + 8 * lane; float w[8], h[8]; unpack8(*(const u32x4*)(WU + (size_t)n * DM + k), w);
                    load8f(mod + 0 * 12288 + 3 * DM + k, h);
#pragma unroll
                    for (int e = 0; e < 8; ++e) s0 += w[e] * h[e];
                    load8f(mod + 1 * 12288 + 3 * DM + k, h);
#pragma unroll
                    for (int e = 0; e < 8; ++e) s1 += w[e] * h[e];
                    load8f(mod + 2 * 12288 + 3 * DM + k, h);
#pragma unroll
                    for (int e = 0; e < 8; ++e) s2 += w[e] * h[e];
                    load8f(mod + 3 * 12288 + 3 * DM + k, h);
#pragma unroll
                    for (int e = 0; e < 8; ++e) s3 += w[e] * h[e]; }
                s0 = wave_sum(s0); s1 = wave_sum(s1); s2 = wave_sum(s2); s3 = wave_sum(s3);
                if (lane == 0) { B2[n] = s0; B2[2 * DFF + n] = s1; B2[4 * DFF + n] = s2; B2[6 * DFF + n] = s3; } }
        }
    } SEAM(1);
    if (IN(2)) {
        pg8::Gemm g{(const bf16_t*)((unsigned char*)p.out + OUT_HN), (const bf16_t*)((unsigned char*)p.out + OUT_WINT), DM, DM, DM, 0, nullptr, nullptr};
        pg8::Order S; S.init(MLAT / 256, NINP / 256, G, c); S.xM0 = MLAT / 256; S.xnM = MCTX / 256; S.xn = 13; S.xlast = 48;
        EpiProj E{(bf16_t*)(p.ws + OFF_XBC), (bf16_t*)(p.ws + OFF_Z), (float*)(p.ws + OFF_DT), p.in[10]};
        pg8::gemm_phase(lds, g, S, E);
        { const int total = (MLAT / 256) * (NINP / 256) + (MCTX / 256) * 13, rem = total % G;
          if (rem == 0) phase_late_weights(p, smem, c, G); else if (c >= rem) phase_late_weights(p, smem, c - rem, G - rem); }
    } SEAM(2);
    if (IN(3)) { phase_conv_pool(p, smem); }
    SEAM(4);
    if (IN(5)) { phase_ssd_mfma(p, smem); } SEAM(5);
    if (IN(6)) { phase_gate_norm(p); } SEAM(6);
    if (IN(7)) {
        pg8::Order S; S.init(MLAT / 256, DM / 256, G, c); S.dual = 1;
        pg8::Gemm g{(const bf16_t*)(p.ws + OFF_YS), (const bf16_t*)(p.ws + OFF_WSSD), DM, DM, DM, 0, (const bf16_t*)(p.ws + OFF_P), (const bf16_t*)(p.ws + OFF_WFOLD)};
        EpiGateDual E{(bf16_t*)(p.ws + OFF_MG), (const bf16_t*)(p.ws + OFF_GS), (const bf16_t*)(p.ws + OFF_GP)};
        pg8::gemm_phase(lds, g, S, E);
    } SEAM(7);
    if (IN(8)) {
        pg8::Gemm g{(const bf16_t*)(p.ws + OFF_MG), (const bf16_t*)(p.ws + OFF_WO), DM, DM, DM, 0, nullptr, nullptr};
        pg8::Order S; S.init(MLAT / 256, DM / 256, G, c);
        EpiRes1 E{(unsigned short*)p.out, p.in[0], mod, p.in[19], (bf16_t*)(p.ws + OFF_H2), (float*)(p.ws + OFF_ROWSS)};
        pg8::gemm_phase(lds, g, S, E);
    }
    SEAM(9);
    if (IN(10)) {
        pg8::Gemm g{(const bf16_t*)(p.ws + OFF_H2), (const bf16_t*)(p.ws + OFF_WUP), DM, DM, DM, 0, nullptr, nullptr};
        pg8::Order S; S.init(MLAT / 256, 2 * DFF / 256, G, c);
        EpiUp E{(bf16_t*)(p.ws + OFF_UPA), (bf16_t*)(p.ws + OFF_UPG), (const float*)(p.ws + OFF_ROWSS), (const float*)(p.ws + OFF_BIAS2)};
        pg8::gemm_phase(lds, g, S, E);
    } SEAM(10);
    if (IN(11)) { phase_ffn_act(p); } SEAM(11);
    if (IN(12)) {
        pg8::Gemm g{(const bf16_t*)(p.ws + OFF_UPA), (const bf16_t*)(p.ws + OFF_WDN), DFF, DFF, DFF, 0, nullptr, nullptr};
        pg8::Order S; S.init(MLAT / 256, DM / 256, G, c);
        EpiRes E{(unsigned short*)(p.ws + OFF_UPG), (const unsigned short*)p.out, mod + 5 * DM};
        pg8::gemm_phase(lds, g, S, E);
    } SEAM(12);
    if (IN(13)) { phase_final_norm(p); }
    if (hi > NPHASES + 1000) cg::this_grid().sync();
#undef IN
#undef SEAM
}

extern "C" void kernel_launch(void* const* d_in, const int* in_sizes, int n_in, void* d_out, int out_size, void* d_ws, size_t ws_size, hipStream_t stream) {
    static int grid = 0;
    if (grid == 0) {
        if (n_in != 25 || out_size != MLAT * DM || ws_size < WS_END) { fprintf(stderr, "kernel_launch: unexpected shapes (n_in %d out %d ws %zu need %zu)\n", n_in, out_size, ws_size, (size_t)WS_END); grid = -1; return; }
        int dev = 0, cus = 0, per_cu = 0;
        (void)hipGetDevice(&dev); (void)hipDeviceGetAttribute(&cus, hipDeviceAttributeMultiprocessorCount, dev);
        if (hipFuncSetAttribute((const void*)mk_fwd, hipFuncAttributeMaxDynamicSharedMemorySize, LDS_BYTES) != hipSuccess) { fprintf(stderr, "kernel_launch: hipFuncSetAttribute failed\n"); grid = -1; return; }
        if (hipOccupancyMaxActiveBlocksPerMultiprocessor(&per_cu, (const void*)mk_fwd, 512, LDS_BYTES) != hipSuccess || per_cu < 1) per_cu = 1;
        (void)hipGetLastError();
        grid = cus * per_cu;
        if (grid <= 0) grid = 256;
    }
    if (grid < 0) return;
    (void)hipMemsetAsync((unsigned char*)d_ws + OFF_MOD, 0, OFF_DT, stream);
    Params p{};
    for (int i = 0; i < 25; ++i) p.in[i] = (const float*)d_in[i];
    p.out = (float*)d_out; p.ws = (unsigned char*)d_ws;
#if MK_MULTI
    for (int ph = 0; ph < NPHASES; ++ph) { p.ph_lo = ph; p.ph_hi = ph + 1; hipLaunchKernelGGL(mk_fwd, dim3(grid), dim3(512), LDS_BYTES, stream, p); }
#else
    p.ph_lo = 0; p.ph_hi = NPHASES;
    void* args[] = {&p};
    hipError_t e = hipLaunchCooperativeKernel((const void*)mk_fwd, dim3(grid), dim3(512), args, LDS_BYTES, stream);
    if (e != hipSuccess) fprintf(stderr, "cooperative launch failed: %s (grid %d)\n", hipGetErrorString(e), grid);
#ifdef PROBE_EXTRA
    { const int extra[] = PROBE_EXTRA; for (int ph : extra) { p.ph_lo = ph; p.ph_hi = ph + 1; hipLaunchKernelGGL(mk_fwd, dim3(grid), dim3(512), LDS_BYTES, stream, p); } }
#endif
#endif
}
```
